# Optimizing an MI355X kernel written in HIP

```python
import math
import jax, jax.numpy as jnp
from jax import lax
import numpy as np

D_MODEL = 1024
BATCH = 32
SEQ = 2048
DEPTH = 2

CTX_LEN = 256
GRID_W = 64
F32 = jnp.float32
EPS = 1e-6

N_MOD = 9
D_FF = 256 * ((8 * D_MODEL // 3 + 255) // 256)
A_INNER = D_MODEL // 2
A_HEADS = 8
A_HEAD_DIM = A_INNER // A_HEADS
A_GROUPS = 2
A_STATE = 64
A_CONV = 5
A_CONV_DIM = A_INNER + 2 * A_GROUPS * A_STATE
A_COLS = A_INNER + A_CONV_DIM + 2 * A_HEADS
SSD_CHUNK = 64
B_WIDTH = D_MODEL // 4
B_GROUP = 16
B_NGROUPS = B_WIDTH // B_GROUP
B_STATE = 64
B_COLS = B_WIDTH
C_WIDTH = D_MODEL // 4
C_HEADS = 4
C_KEY = C_WIDTH // C_HEADS
C_VAL = C_WIDTH // C_HEADS
C_COLS = 5 * C_WIDTH
HG_CHUNK = 64

MIX_WIDTH = A_INNER + B_WIDTH + C_WIDTH
IN_COLS = A_COLS + B_COLS + C_COLS

kernel_name = "hybrid_ssd_s5_hgrn2_dit_block"


def rms_norm(x):
    xf = x.astype(F32)
    return (xf * lax.rsqrt(jnp.mean(xf * xf, axis=-1, keepdims=True) + EPS)).astype(x.dtype)


def modulate(h, shift, scale):
    return rms_norm(h) * (1 + scale) + shift


def swiglu(u, w_in, w_out):
    gate, up = jnp.split(u @ w_in, 2, axis=-1)
    return (jax.nn.silu(gate) * up) @ w_out


def masked_exp(diff, mask):
    return jnp.where(mask, jnp.exp(jnp.where(mask, diff, 0.0)), 0.0)


def _flip(t):
    return jnp.flip(t, axis=1)


def raster_to_column(t, rows):
    b, s, d = t.shape
    return t.reshape(b, rows, GRID_W, d).transpose(0, 2, 1, 3).reshape(b, s, d)


def column_to_raster(t, rows):
    b, s, d = t.shape
    return t.reshape(b, GRID_W, rows, d).transpose(0, 2, 1, 3).reshape(b, s, d)


def depthwise_conv(x, w, b):
    pad = A_CONV // 2
    y = lax.conv_general_dilated(x, w[:, None, :].astype(x.dtype), window_strides=(1,),
                                 padding=[(pad, pad)], dimension_numbers=('NWC', 'WIO', 'NWC'),
                                 feature_group_count=x.shape[-1])
    return y + b.astype(x.dtype)


def ssd_chunked(x, dt, a, bm, cm, s0):
    bsz, L, H, P = x.shape
    N = bm.shape[-1]
    Q = SSD_CHUNK
    nc = L // Q
    x = x.reshape(bsz, nc, Q, H, P)
    dt = dt.reshape(bsz, nc, Q, H)
    bm = bm.reshape(bsz, nc, Q, H, N)
    cm = cm.reshape(bsz, nc, Q, H, N)
    cum = jnp.cumsum(dt * a, axis=2)
    tri = jnp.tril(jnp.ones((Q, Q), dtype=bool))[None, None, :, :, None]
    decay = masked_exp(cum[:, :, :, None, :] - cum[:, :, None, :, :], tri)
    scores = jnp.einsum('bcihn,bcjhn->bcijh', cm, bm) * decay * dt[:, :, None, :, :]
    y_intra = jnp.einsum('bcijh,bcjhp->bcihp', scores, x)
    w_end = jnp.exp(cum[:, :, -1:, :] - cum) * dt
    chunk_states = jnp.einsum('bcjh,bcjhn,bcjhp->bchpn', w_end, bm, x)
    chunk_decay = jnp.exp(cum[:, :, -1, :])

    def step(s, inp):
        dec, cs = inp
        return s * dec[:, :, None, None] + cs, s

    s_fin, s_in = lax.scan(step, s0, (jnp.moveaxis(chunk_decay, 1, 0), jnp.moveaxis(chunk_states, 1, 0)))
    s_in = jnp.moveaxis(s_in, 0, 1)
    y_inter = jnp.einsum('bcihn,bchpn->bcihp', cm, s_in) * jnp.exp(cum)[..., None]
    return (y_intra + y_inter).reshape(bsz, L, H, P), s_fin


def mamba2_mixer(p, conv_w, conv_b, dt_bias, a_log, d_skip, norm_w, init):
    bsz, L, _ = p.shape
    z, xbc, dt_raw = jnp.split(p, [A_INNER, A_INNER + A_CONV_DIM], axis=-1)
    xbc = jax.nn.silu(depthwise_conv(xbc, conv_w, conv_b))
    xs, bm, cm = jnp.split(xbc, [A_INNER, A_INNER + A_GROUPS * A_STATE], axis=-1)
    rep = A_HEADS // A_GROUPS
    xs = xs.astype(F32).reshape(bsz, L, A_HEADS, A_HEAD_DIM)
    bm = jnp.repeat(bm.astype(F32).reshape(bsz, L, A_GROUPS, A_STATE), rep, axis=2)
    cm = jnp.repeat(cm.astype(F32).reshape(bsz, L, A_GROUPS, A_STATE), rep, axis=2)
    dt = jax.nn.softplus(dt_raw.astype(F32).reshape(bsz, L, 2, A_HEADS) + dt_bias.astype(F32))
    a = -jnp.exp(a_log.astype(F32))
    y_f, s_f = ssd_chunked(xs, dt[:, :, 0], a[0], bm, cm, init[0])
    y_b, s_b = ssd_chunked(_flip(xs), _flip(dt[:, :, 1]), a[1], _flip(bm), _flip(cm), init[1])
    y = y_f + _flip(y_b) + d_skip.astype(F32)[:, None] * xs
    y = y.reshape(bsz, L, A_INNER) * jax.nn.silu(z.astype(F32))
    y = rms_norm(y) * norm_w.astype(F32)
    return y.astype(p.dtype), jnp.stack([s_f, s_b])


def _complex_affine_combine(e1, e2):
    a1r, a1i, b1r, b1i = e1
    a2r, a2i, b2r, b2i = e2
    return (a1r * a2r - a1i * a2i, a1r * a2i + a1i * a2r,
            a2r * b1r - a2i * b1i + b2r, a2r * b1i + a2i * b1r + b2i)


def s5_scan(u, lam_re, lam_im, log_step, b_re, b_im, s0_re, s0_im):
    L = u.shape[1]
    lam_re = lam_re.astype(F32)
    lam_im = lam_im.astype(F32)
    step = jnp.exp(log_step.astype(F32))[:, None]
    mag = jnp.exp(lam_re * step)
    ar = mag * jnp.cos(lam_im * step)
    ai = mag * jnp.sin(lam_im * step)
    den = lam_re * lam_re + lam_im * lam_im
    nr = ar - 1.0
    kr = (nr * lam_re + ai * lam_im) / den
    ki = (ai * lam_re - nr * lam_im) / den
    b_re = b_re.astype(F32)
    b_im = b_im.astype(F32)
    br = kr[..., None] * b_re - ki[..., None] * b_im
    bi = kr[..., None] * b_im + ki[..., None] * b_re
    vr = jnp.einsum('gnc,blgc->blgn', br, u)
    vi = jnp.einsum('gnc,blgc->blgn', bi, u)
    vr = vr.at[:, 0].add(ar * s0_re - ai * s0_im)
    vi = vi.at[:, 0].add(ar * s0_im + ai * s0_re)
    shape_a = (1, L) + ar.shape
    elems = (jnp.broadcast_to(ar, shape_a), jnp.broadcast_to(ai, shape_a), vr, vi)
    _, _, xr, xi = lax.associative_scan(_complex_affine_combine, elems, axis=1)
    return xr, xi


def s5_mixer(p, lam_re, lam_im, log_step, b_re, b_im, c_re, c_im, d_skip, glu_w, glu_b, init_re, init_im):
    bsz, L, _ = p.shape
    pf = p.astype(F32)
    u = pf.reshape(bsz, L, B_NGROUPS, B_GROUP)
    c_re = c_re.astype(F32)
    c_im = c_im.astype(F32)
    xr_f, xi_f = s5_scan(u, lam_re[0], lam_im[0], log_step[0], b_re[0], b_im[0], init_re[0], init_im[0])
    xr_b, xi_b = s5_scan(_flip(u), lam_re[1], lam_im[1], log_step[1], b_re[1], b_im[1], init_re[1], init_im[1])
    y_f = jnp.einsum('gcn,blgn->blgc', c_re[0], xr_f) - jnp.einsum('gcn,blgn->blgc', c_im[0], xi_f)
    y_b = jnp.einsum('gcn,blgn->blgc', c_re[1], xr_b) - jnp.einsum('gcn,blgn->blgc', c_im[1], xi_b)
    y = (y_f + _flip(y_b)).reshape(bsz, L, B_WIDTH) + d_skip.astype(F32) * pf
    y = jax.nn.gelu(y)
    y = y * jax.nn.sigmoid(y @ glu_w.astype(F32) + glu_b.astype(F32))
    fin_re = jnp.stack([xr_f[:, -1], xr_b[:, -1]])
    fin_im = jnp.stack([xi_f[:, -1], xi_b[:, -1]])
    return y.astype(p.dtype), fin_re, fin_im


def hgrn2_chunked(q, log_f, k, v, s0):
    bsz, L, H, K = q.shape
    V = v.shape[-1]
    nc = L // HG_CHUNK

    def chunks(t):
        return jnp.moveaxis(t.reshape((bsz, nc, HG_CHUNK) + t.shape[2:]), 1, 0)

    tri = jnp.tril(jnp.ones((HG_CHUNK, HG_CHUNK), dtype=bool))[None, :, :, None, None]

    def step(s, inp):
        qc, lfc, kc, vc = inp
        cum = jnp.cumsum(lfc, axis=1)
        decay = masked_exp(cum[:, :, None] - cum[:, None, :], tri)
        scores = jnp.einsum('bihk,bjhk,bijhk->bijh', qc, kc, decay)
        o = jnp.einsum('bijh,bjhv->bihv', scores, vc) + jnp.einsum('bihk,bhkv->bihv', qc * jnp.exp(cum), s)
        w = kc * jnp.exp(cum[:, -1:] - cum)
        s_new = s * jnp.exp(cum[:, -1])[..., None] + jnp.einsum('bjhk,bjhv->bhkv', w, vc)
        return s_new, o

    s_fin, o = lax.scan(step, s0, (chunks(q), chunks(log_f), chunks(k), chunks(v)))
    return jnp.moveaxis(o, 0, 1).reshape(bsz, L, H, V), s_fin


def hgrn2_mixer(p, lower, norm_w, init):
    bsz, L, _ = p.shape
    q, f_raw, i, g = jnp.split(p, [C_WIDTH, 3 * C_WIDTH, 4 * C_WIDTH], axis=-1)
    q = jax.nn.silu(q.astype(F32)).reshape(bsz, L, C_HEADS, C_KEY)
    v = i.astype(F32).reshape(bsz, L, C_HEADS, C_VAL)
    f_raw = f_raw.astype(F32).reshape(bsz, L, 2, C_HEADS, C_KEY)
    lower = lower.astype(F32).reshape(2, C_HEADS, C_KEY)
    outs, finals = [], []
    for d in range(2):
        zf = f_raw[:, :, d]
        lb = lower[d]
        f = lb + (1.0 - lb) * jax.nn.sigmoid(zf)
        log_f = jnp.log(f)
        k = 1.0 - f
        if d == 0:
            o, s = hgrn2_chunked(q, log_f, k, v, init[0])
        else:
            o, s = hgrn2_chunked(_flip(q), _flip(log_f), _flip(k), _flip(v), init[1])
            o = _flip(o)
        outs.append(o)
        finals.append(s)
    o = rms_norm(outs[0] + outs[1]) * norm_w.astype(F32).reshape(C_HEADS, C_VAL)
    o = o.reshape(bsz, L, C_WIDTH) * jax.nn.silu(g.astype(F32))
    return o.astype(p.dtype), jnp.stack(finals)


def token_mixers(p_ctx, p_lat, conv_w, conv_b, dt_bias, a_log, a_d, a_norm_w,
                 lam_re, lam_im, log_step, b_re, b_im, c_re, c_im, s5_d, glu_w, glu_b,
                 lower, hg_norm_w):
    bsz = p_ctx.shape[0]
    cuts = [A_COLS, A_COLS + B_COLS]
    pa_c, pb_c, pc_c = jnp.split(p_ctx, cuts, axis=-1)
    pa_l, pb_l, pc_l = jnp.split(p_lat, cuts, axis=-1)
    za = jnp.zeros((2, bsz, A_HEADS, A_HEAD_DIM, A_STATE), F32)
    ya_c, sa = mamba2_mixer(pa_c, conv_w, conv_b, dt_bias, a_log, a_d, a_norm_w, za)
    ya_l, _ = mamba2_mixer(pa_l, conv_w, conv_b, dt_bias, a_log, a_d, a_norm_w, sa)
    zb = jnp.zeros((2, bsz, B_NGROUPS, B_STATE), F32)
    yb_c, sb_re, sb_im = s5_mixer(pb_c, lam_re, lam_im, log_step, b_re, b_im, c_re, c_im, s5_d, glu_w, glu_b, zb, zb)
    yb_l, _, _ = s5_mixer(pb_l, lam_re, lam_im, log_step, b_re, b_im, c_re, c_im, s5_d, glu_w, glu_b, sb_re, sb_im)
    zc = jnp.zeros((2, bsz, C_HEADS, C_KEY, C_VAL), F32)
    yc_c, sc = hgrn2_mixer(pc_c, lower, hg_norm_w, zc)
    yc_l, _ = hgrn2_mixer(pc_l, lower, hg_norm_w, sc)
    return (jnp.concatenate([ya_c, yb_c, yc_c], axis=-1), jnp.concatenate([ya_l, yb_l, yc_l], axis=-1))


def setup_inputs(seed: int = 0) -> dict:
    key = jax.random.key(seed)
    ks = jax.random.split(key, 32)
    dm = D_MODEL

    def nrm(k, shape, scale):
        return scale * jax.random.normal(k, shape, F32)

    x = nrm(ks[0], (BATCH, SEQ, dm), 1.0)
    c = nrm(ks[1], (BATCH, dm), 1.0)
    ctx = nrm(ks[2], (BATCH, CTX_LEN, dm), 1.0)
    c_ctx = nrm(ks[3], (dm,), 1.0)
    mod_w = nrm(ks[4], (DEPTH, dm, N_MOD * dm), dm ** -0.5)
    mod_b = nrm(ks[5], (DEPTH, N_MOD * dm), 0.01)
    ffn_w_in = nrm(ks[6], (DEPTH, 2, dm, 2 * D_FF), dm ** -0.5)
    ffn_w_out = nrm(ks[7], (DEPTH, 2, D_FF, dm), D_FF ** -0.5)
    w_in = nrm(ks[8], (DEPTH, dm, IN_COLS), dm ** -0.5)
    w_out = nrm(ks[9], (DEPTH, MIX_WIDTH, dm), MIX_WIDTH ** -0.5)
    a_conv_w = nrm(ks[10], (DEPTH, A_CONV, A_CONV_DIM), A_CONV ** -0.5)
    a_conv_b = nrm(ks[11], (DEPTH, A_CONV_DIM), 0.01)
    dt0 = jnp.exp(jax.random.uniform(ks[12], (DEPTH, 2, A_HEADS), F32, math.log(1e-3), math.log(1e-1)))
    a_dt_bias = dt0 + jnp.log(-jnp.expm1(-dt0))
    a_log = jnp.log(jax.random.uniform(ks[13], (DEPTH, 2, A_HEADS), F32, 1.0, 16.0))
    a_d = 1.0 + nrm(ks[14], (DEPTH, A_HEADS), 0.01)
    a_norm_w = 1.0 + nrm(ks[15], (DEPTH, A_INNER), 0.01)
    s5_lam_re = -0.5 + nrm(ks[16], (DEPTH, 2, B_NGROUPS, B_STATE), 0.01)
    s5_lam_im = math.pi * jnp.arange(B_STATE, dtype=F32) + nrm(ks[17], (DEPTH, 2, B_NGROUPS, B_STATE), 0.01)
    s5_log_step = jax.random.uniform(ks[18], (DEPTH, 2, B_NGROUPS), F32, math.log(1e-3), math.log(1e-1))
    s5_b_re = nrm(ks[19], (DEPTH, 2, B_NGROUPS, B_STATE, B_GROUP), (2 * B_GROUP) ** -0.5)
    s5_b_im = nrm(ks[20], (DEPTH, 2, B_NGROUPS, B_STATE, B_GROUP), (2 * B_GROUP) ** -0.5)
    s5_c_re = nrm(ks[21], (DEPTH, 2, B_NGROUPS, B_GROUP, B_STATE), (2 * B_STATE) ** -0.5)
    s5_c_im = nrm(ks[22], (DEPTH, 2, B_NGROUPS, B_GROUP, B_STATE), (2 * B_STATE) ** -0.5)
    s5_d = nrm(ks[23], (DEPTH, B_WIDTH), 1.0)
    s5_glu_w = nrm(ks[24], (DEPTH, B_WIDTH, B_WIDTH), B_WIDTH ** -0.5)
    s5_glu_b = nrm(ks[25], (DEPTH, B_WIDTH), 0.01)
    hg_lb_logits = nrm(ks[26], (DEPTH, 2, C_WIDTH), 0.5)
    hg_norm_w = 1.0 + nrm(ks[27], (DEPTH, C_WIDTH), 0.01)
    final_norm_w = 1.0 + nrm(ks[28], (dm,), 0.01)
    return {"x": x, "c": c, "ctx": ctx, "c_ctx": c_ctx, "mod_w": mod_w, "mod_b": mod_b,
            "ffn_w_in": ffn_w_in, "ffn_w_out": ffn_w_out, "w_in": w_in, "w_out": w_out,
            "a_conv_w": a_conv_w, "a_conv_b": a_conv_b, "a_dt_bias": a_dt_bias, "a_log": a_log,
            "a_d": a_d, "a_norm_w": a_norm_w, "s5_lam_re": s5_lam_re, "s5_lam_im": s5_lam_im,
            "s5_log_step": s5_log_step, "s5_b_re": s5_b_re, "s5_b_im": s5_b_im, "s5_c_re": s5_c_re,
            "s5_c_im": s5_c_im, "s5_d": s5_d, "s5_glu_w": s5_glu_w, "s5_glu_b": s5_glu_b,
            "hg_lb_logits": hg_lb_logits, "hg_norm_w": hg_norm_w, "final_norm_w": final_norm_w}


def reference(x, c, ctx, c_ctx, mod_w, mod_b, ffn_w_in, ffn_w_out, w_in, w_out,
              a_conv_w, a_conv_b, a_dt_bias, a_log, a_d, a_norm_w,
              s5_lam_re, s5_lam_im, s5_log_step, s5_b_re, s5_b_im, s5_c_re, s5_c_im,
              s5_d, s5_glu_w, s5_glu_b, hg_lb_logits, hg_norm_w, final_norm_w):
    bsz, seq, dm = x.shape
    rows = seq // GRID_W
    p_lb = jax.nn.softmax(hg_lb_logits.astype(F32), axis=0)
    lower_bounds = jnp.cumsum(p_lb, axis=0) - p_lb[:1]
    h_lat, h_ctx = x, ctx
    for l in range(DEPTH):
        last = l == DEPTH - 1
        col_major = l % 2 == 1
        m_lat = (jax.nn.silu(c) @ mod_w[l] + mod_b[l]).reshape(bsz, N_MOD, 1, dm)
        m_ctx = (jax.nn.silu(c_ctx) @ mod_w[l] + mod_b[l]).reshape(N_MOD, dm)
        h_lat = h_lat + 0.5 * m_lat[:, 2] * swiglu(modulate(h_lat, m_lat[:, 0], m_lat[:, 1]), ffn_w_in[l, 0], ffn_w_out[l, 0])
        h_ctx = h_ctx + 0.5 * m_ctx[2] * swiglu(modulate(h_ctx, m_ctx[0], m_ctx[1]), ffn_w_in[l, 0], ffn_w_out[l, 0])
        u_lat = modulate(h_lat, m_lat[:, 3], m_lat[:, 4])
        u_ctx = modulate(h_ctx, m_ctx[3], m_ctx[4])
        if col_major:
            u_lat = raster_to_column(u_lat, rows)
        mix_ctx, mix_lat = token_mixers(u_ctx @ w_in[l], u_lat @ w_in[l],
                                        a_conv_w[l], a_conv_b[l], a_dt_bias[l], a_log[l], a_d[l], a_norm_w[l],
                                        s5_lam_re[l], s5_lam_im[l], s5_log_step[l], s5_b_re[l], s5_b_im[l],
                                        s5_c_re[l], s5_c_im[l], s5_d[l], s5_glu_w[l], s5_glu_b[l],
                                        lower_bounds[l], hg_norm_w[l])
        y_lat = mix_lat @ w_out[l]
        if col_major:
            y_lat = column_to_raster(y_lat, rows)
        h_lat = h_lat + m_lat[:, 5] * y_lat
        h_lat = h_lat + 0.5 * m_lat[:, 8] * swiglu(modulate(h_lat, m_lat[:, 6], m_lat[:, 7]), ffn_w_in[l, 1], ffn_w_out[l, 1])
        if not last:
            h_ctx = h_ctx + m_ctx[5] * (mix_ctx @ w_out[l])
            h_ctx = h_ctx + 0.5 * m_ctx[8] * swiglu(modulate(h_ctx, m_ctx[6], m_ctx[7]), ffn_w_in[l, 1], ffn_w_out[l, 1])
    return rms_norm(h_lat) * final_norm_w
```

```cpp
#define HG_ON_SSD 1
#define PG8_WGM 4
#include <hip/hip_runtime.h>
#include <hip/hip_cooperative_groups.h>
#include <cstdio>
#include <cstdint>
namespace cg = cooperative_groups;
#ifndef PG8_WGM
#define PG8_WGM 8
#endif
namespace pg8 {
#define PG8_LAS __attribute__((address_space(3)))
typedef unsigned short bf16_t;
typedef short bf16x8 __attribute__((ext_vector_type(8)));
typedef float f32x4 __attribute__((ext_vector_type(4)));
typedef unsigned u32x4 __attribute__((ext_vector_type(4)));
constexpr int BM = 256, BK = 64, HALF = 128, HTB = HALF * BK * 2  , STAGE_BYTES = 8 * HTB, NXCD = 8, WGM = PG8_WGM;

__host__ __device__ __forceinline__ int lds_byte(int r, int c) { const int st = (r >> 4) * 2 + (c >> 5), rr = r & 15, cc = c & 31, ob = rr * 64 + cc * 2; return st * 1024 + (ob ^ (((ob >> 9) & 1) << 5)); }
__host__ __device__ __forceinline__ void stage_rc(int b, int& R, int& C) { const int st = b / 1024, sb = b % 1024, swz = sb ^ (((sb >> 9) & 1) << 5); R = (st >> 1) * 16 + swz / 64; C = (st & 1) * 32 + (swz % 64) / 2; }
__host__ __device__ __forceinline__ int perm32(int rho) { const int n = rho >> 4, i = rho & 15; return 8 * (i >> 2) + 4 * n + (i & 3); }

struct Unit { int pm, pn; };
struct Gemm { const bf16_t* A; const bf16_t* Bt; int M, N, K; };

struct StaticOrder {
    int nM, nN, nwg, G, c, rev;
    __host__ __device__ void init(int M, int N, int G_, int c_) { nM = M / BM; nN = N / BM; nwg = nM * nN; G = G_; c = c_; rev = 0; }
    __host__ __device__ bool next(int i, Unit& u) const {
        const long L = (long)i * G + c; if (L >= nwg) return false;
        int wgid = (int)L; { const int q = nwg / NXCD, r = nwg % NXCD, xcd = wgid % NXCD, off = wgid / NXCD; wgid = (xcd < r ? xcd * (q + 1) : r * (q + 1) + (xcd - r) * q) + off; }
        const int nig = WGM * nN, gid = wgid / nig, fm = gid * WGM, gsz = (nM - fm) < WGM ? (nM - fm) : WGM;
        u.pm = fm + ((wgid % nig) % gsz); u.pn = (wgid % nig) / gsz; if (rev) u.pm = nM - 1 - u.pm; return true;
    }
    __device__ __forceinline__ void a_ready(const Unit&) const {}
    __device__ __forceinline__ void done(const Unit&) const {}
};
__device__ __forceinline__ unsigned cvt_pk_bf16(float lo, float hi) { unsigned r; asm volatile("v_cvt_pk_bf16_f32 %0, %1, %2" : "=v"(r) : "v"(lo), "v"(hi)); return r; }

template <class Epi, class Sched, bool ALIGN_EPI = false, bool SP2 = false>
__device__ __forceinline__ void gemm_phase(PG8_LAS unsigned char* lds, const Gemm g, const Sched& S, const Epi& E, const int tid) {
    const int wid = __builtin_amdgcn_readfirstlane(tid >> 6), lane = tid & 63, wr = wid >> 2, wc = wid & 3, fr = lane & 15, fq = lane >> 4;
    const int K = g.K, nt = K / BK;
    unsigned voffA[2], voffB[2];
#pragma unroll
    for (int i = 0; i < 2; ++i) { int R, C; stage_rc(tid * 16 + i * 8192, R, C); const int Rb = Epi::PERM ? ((R & ~31) + perm32(R & 31)) : R;
        voffA[i] = (unsigned)(R * K + C) * 2u; voffB[i] = (unsigned)(Rb * K + C) * 2u; }
    const size_t kstep = (size_t)(BK * 2);
    const size_t hstep = (size_t)HALF * K * 2;
    const size_t tstep = 2 * hstep;
    const unsigned ldsw = (unsigned)wid * 1024u;
    const int aoff = lds_byte(wr * 64 + fr, fq * 8), boff = lds_byte(wc * 32 + fr, fq * 8);
#define PG8_SA(b, h) (((b) * 2 + (h)) * HTB)
#define PG8_SB(b, h) ((4 + (b) * 2 + (h)) * HTB)
#define PG8_STAGE(bufoff, gbase, voff) do { _Pragma("unroll") for (int _i = 0; _i < 2; ++_i) \
        __builtin_amdgcn_global_load_lds((const unsigned*)((const char*)(gbase) + (voff)[_i]), (PG8_LAS unsigned*)(lds + (bufoff) + ldsw + _i * 8192), 16, 0, 0); } while (0)
#define PG8_LDA(dst, b, h) do { _Pragma("unroll") for (int m = 0; m < 4; ++m) _Pragma("unroll") for (int k = 0; k < 2; ++k) dst[m][k] = *(const PG8_LAS bf16x8*)(lds + PG8_SA(b, h) + aoff + m * 2048 + k * 1024); } while (0)
#define PG8_LDB(dst, b, h) do { _Pragma("unroll") for (int n = 0; n < 2; ++n) _Pragma("unroll") for (int k = 0; k < 2; ++k) dst[n][k] = *(const PG8_LAS bf16x8*)(lds + PG8_SB(b, h) + boff + n * 2048 + k * 1024); } while (0)
#define PG8_MMA(ai, bj, At, Bt) do { __builtin_amdgcn_s_setprio(1); _Pragma("unroll") for (int m = 0; m < 4; ++m) _Pragma("unroll") for (int n = 0; n < 2; ++n) _Pragma("unroll") for (int k = 0; k < 2; ++k) \
        acc[ai][bj][m][n] = __builtin_amdgcn_mfma_f32_16x16x32_bf16(Bt[n][k], At[m][k], acc[ai][bj][m][n], 0, 0, 0); __builtin_amdgcn_s_setprio(0); } while (0)
#define PG8_WAIT_V(n) asm volatile("s_waitcnt vmcnt(" #n ")" ::: "memory")
#define PG8_WAIT_L(n) asm volatile("s_waitcnt lgkmcnt(" #n ")" ::: "memory")
#define PG8_BAR __builtin_amdgcn_s_barrier()
#define PG8_SCHED __builtin_amdgcn_sched_barrier(0)
    Unit cur, nxt; int ui = 0;
    if (!S.next(0, cur)) return;
    f32x4 acc[2][2][4][2];
#pragma unroll
    for (int a = 0; a < 2; ++a)
#pragma unroll
        for (int b = 0; b < 2; ++b)
#pragma unroll
            for (int m = 0; m < 4; ++m)
#pragma unroll
                for (int n = 0; n < 2; ++n) acc[a][b][m][n] = (f32x4){0.f, 0.f, 0.f, 0.f};
    bf16x8 At[4][2], B0[2][2], B1[2][2];
    const char* cA = (const char*)g.A + (size_t)cur.pm * tstep; const char* cB = (const char*)g.Bt + (size_t)cur.pn * tstep;
    S.a_ready(cur);
    if constexpr (SP2) {
        PG8_STAGE(PG8_SB(0, 0), cB, voffB); PG8_STAGE(PG8_SB(0, 1), cB + hstep, voffB); PG8_STAGE(PG8_SA(0, 0), cA, voffA); PG8_STAGE(PG8_SA(0, 1), cA + hstep, voffA);
        if (wr == 1) PG8_BAR;
        PG8_WAIT_V(2); PG8_BAR;
        PG8_STAGE(PG8_SB(1, 0), cB + kstep, voffB); PG8_STAGE(PG8_SA(1, 0), cA + kstep, voffA); PG8_STAGE(PG8_SB(1, 1), cB + hstep + kstep, voffB);
        PG8_WAIT_V(6); PG8_BAR;
    } else {
        PG8_STAGE(PG8_SB(0, 0), cB, voffB); PG8_STAGE(PG8_SA(0, 0), cA, voffA); PG8_STAGE(PG8_SB(0, 1), cB + hstep, voffB); PG8_STAGE(PG8_SA(0, 1), cA + hstep, voffA);
        if (wr == 1) PG8_BAR;
        PG8_WAIT_V(4); PG8_BAR;
        PG8_STAGE(PG8_SB(1, 0), cB + kstep, voffB); PG8_STAGE(PG8_SA(1, 0), cA + kstep, voffA); PG8_STAGE(PG8_SB(1, 1), cB + hstep + kstep, voffB);
        PG8_WAIT_V(6); PG8_BAR;
    }
    for (;;) {
        const bool has_next = S.next(ui + 1, nxt);
        const char* nA = has_next ? (const char*)g.A + (size_t)nxt.pm * tstep : cA; const char* nB = has_next ? (const char*)g.Bt + (size_t)nxt.pn * tstep : cB;
        for (int t = 0; t < nt; t += 2) {
            const bool last = (t == nt - 2);
            const char* a1 = cA + (size_t)(t + 1) * kstep;
            const char* a2 = last ? nA : cA + (size_t)(t + 2) * kstep; const char* b2 = last ? nB : cB + (size_t)(t + 2) * kstep;
            const char* a3 = a2 + kstep; const char* b3 = b2 + kstep;
            if (last && has_next) S.a_ready(nxt);
            if constexpr (SP2) {
            PG8_LDB(B0, 0, 0); PG8_LDB(B1, 0, 1); PG8_SCHED; PG8_LDA(At, 0, 0); PG8_STAGE(PG8_SA(1, 1), a1 + hstep, voffA);
            PG8_WAIT_V(8); PG8_WAIT_L(0); PG8_BAR; PG8_MMA(0, 0, At, B0); PG8_MMA(0, 1, At, B1); PG8_BAR; PG8_SCHED;
            PG8_LDA(At, 0, 1); PG8_STAGE(PG8_SB(0, 0), b2, voffB); PG8_STAGE(PG8_SB(0, 1), b2 + hstep, voffB); PG8_STAGE(PG8_SA(0, 0), a2, voffA);
            PG8_WAIT_V(8); PG8_WAIT_L(0); PG8_BAR; PG8_MMA(1, 0, At, B0); PG8_MMA(1, 1, At, B1); PG8_BAR; PG8_SCHED;
            PG8_LDB(B0, 1, 0); PG8_LDB(B1, 1, 1); PG8_SCHED; PG8_LDA(At, 1, 0); PG8_STAGE(PG8_SA(0, 1), a2 + hstep, voffA);
            PG8_WAIT_V(8); PG8_WAIT_L(0); PG8_BAR; PG8_MMA(0, 0, At, B0); PG8_MMA(0, 1, At, B1); PG8_BAR; PG8_SCHED;
            PG8_LDA(At, 1, 1); PG8_STAGE(PG8_SB(1, 0), b3, voffB); PG8_STAGE(PG8_SB(1, 1), b3 + hstep, voffB); PG8_STAGE(PG8_SA(1, 0), a3, voffA);
            PG8_WAIT_V(8); PG8_WAIT_L(0); PG8_BAR; PG8_MMA(1, 0, At, B0); PG8_MMA(1, 1, At, B1); PG8_BAR; PG8_SCHED;
            } else {
            PG8_LDB(B0, 0, 0); PG8_SCHED; PG8_LDA(At, 0, 0); PG8_STAGE(PG8_SA(1, 1), a1 + hstep, voffA);
            PG8_WAIT_L(8); PG8_BAR; PG8_WAIT_L(0); PG8_MMA(0, 0, At, B0); PG8_BAR; PG8_SCHED;
            PG8_LDB(B1, 0, 1); PG8_STAGE(PG8_SB(0, 0), b2, voffB);
            PG8_BAR; PG8_WAIT_L(0); PG8_MMA(0, 1, At, B1); PG8_BAR;
            PG8_LDA(At, 0, 1); PG8_STAGE(PG8_SA(0, 0), a2, voffA);
            PG8_BAR; PG8_WAIT_L(0); PG8_MMA(1, 0, At, B0); PG8_BAR; PG8_SCHED;
            PG8_STAGE(PG8_SB(0, 1), b2 + hstep, voffB);
            PG8_WAIT_V(6); PG8_BAR; PG8_MMA(1, 1, At, B1); PG8_BAR;
            PG8_LDB(B0, 1, 0); PG8_SCHED; PG8_LDA(At, 1, 0); PG8_STAGE(PG8_SA(0, 1), a2 + hstep, voffA);
            PG8_WAIT_L(8); PG8_BAR; PG8_WAIT_L(0); PG8_MMA(0, 0, At, B0); PG8_BAR; PG8_SCHED;
            PG8_LDB(B1, 1, 1); PG8_STAGE(PG8_SB(1, 0), b3, voffB);
            PG8_BAR; PG8_WAIT_L(0); PG8_MMA(0, 1, At, B1); PG8_BAR;
            PG8_LDA(At, 1, 1); PG8_STAGE(PG8_SA(1, 0), a3, voffA);
            PG8_BAR; PG8_WAIT_L(0); PG8_MMA(1, 0, At, B0); PG8_BAR; PG8_SCHED;
            PG8_STAGE(PG8_SB(1, 1), b3 + hstep, voffB);
            PG8_WAIT_V(6); PG8_BAR; PG8_MMA(1, 1, At, B1); PG8_BAR;
            }
        }
        if constexpr (ALIGN_EPI) { if (wr == 0) PG8_BAR; }
        if constexpr (!Epi::AFTER_DRAIN) { E(acc, cur, wr, wc, fr, fq, ui); S.done(cur); }
        if (!has_next) break;
#pragma unroll
        for (int a = 0; a < 2; ++a)
#pragma unroll
            for (int b = 0; b < 2; ++b)
#pragma unroll
                for (int m = 0; m < 4; ++m)
#pragma unroll
                    for (int n = 0; n < 2; ++n) acc[a][b][m][n] = (f32x4){0.f, 0.f, 0.f, 0.f};
        cur = nxt; cA = nA; cB = nB; ++ui;
        if constexpr (ALIGN_EPI) { if (wr == 1) PG8_BAR; }
    }
    PG8_WAIT_V(0);
    if constexpr (!ALIGN_EPI) { if (wr == 0) PG8_BAR; }
    PG8_BAR;
    if constexpr (Epi::AFTER_DRAIN) { E.fused(acc, cur, wr, wc, fr, fq, lds, wid, lane); S.done(cur); }
#undef PG8_SA
#undef PG8_SB
#undef PG8_STAGE
#undef PG8_LDA
#undef PG8_LDB
#undef PG8_MMA
#undef PG8_WAIT_V
#undef PG8_WAIT_L
#undef PG8_BAR
#undef PG8_SCHED
}
}
#define LAS __attribute__((address_space(3)))
typedef unsigned short bf16_t;
typedef float f32x4 __attribute__((ext_vector_type(4)));
typedef float f32x2 __attribute__((ext_vector_type(2)));
typedef unsigned u32x4 __attribute__((ext_vector_type(4)));
typedef unsigned u32x2 __attribute__((ext_vector_type(2)));
typedef short bf16x8 __attribute__((ext_vector_type(8)));

constexpr int DM = 1024, NBATCH = 32, SEQ = 2048, CTXL = 256, DFF = 2816, INC = 2832, INCP = 3072;
constexpr int MLAT = NBATCH * SEQ, MCTX = NBATCH * CTXL, MALL = MLAT + MCTX;
constexpr int MODW = 9 * DM;
constexpr float EPS = 1e-6f;
constexpr int PC_XBC = 512, PC_DT = 1280, PC_S5 = 1296, PC_Q = 1552, PC_F = 1808, PC_I = 2320, PC_G = 2576;
constexpr int NSTEP = CTXL + SEQ;

constexpr size_t MiB = 1u << 20;
constexpr size_t WS_MOD = 1 * MiB;
constexpr size_t WS_LB = 3 * MiB + 512 * 1024;
constexpr size_t WS_MODP = 987 * MiB;
constexpr size_t WS_W = 4 * MiB, W_LAYER = 42 * MiB;
constexpr size_t WO_FI = 0, WO_FO = 22 * MiB, WO_WIN = 33 * MiB, WO_WOUT = 39 * MiB, WO_GLU = 41 * MiB;
constexpr size_t FI_BYTES = 11 * MiB, FO_BYTES = 5767168;
constexpr size_t WS_HCTX = 88 * MiB, WS_U = 120 * MiB, WS_P = 264 * MiB, WS_YF = 663 * MiB, WS_YB = 807 * MiB, WS_YBUF = 951 * MiB, WS_SS = 1007 * MiB, WS_BIAS = 1012 * MiB, WS_END = 1017 * MiB;
constexpr int LDS_BYTES = 163840;
constexpr int BIAS_LD = 5632, BIAS_TAB = 33 * BIAS_LD;
constexpr int NTHREADS = 512;

struct Params { const float* in[29]; float* out; unsigned char* ws; int ph_lo, ph_hi; };
typedef __attribute__((address_space(4))) const unsigned long long* kaptr_t;
struct KP { kaptr_t ka;
    __device__ __forceinline__ const float* in(int i) const { return (const float*)(const __attribute__((address_space(1))) float*)ka[i]; }
    __device__ __forceinline__ float* out() const { return (float*)(__attribute__((address_space(1))) float*)ka[29]; }
    __device__ __forceinline__ unsigned char* ws() const { return (unsigned char*)(__attribute__((address_space(1))) unsigned char*)ka[30]; }
    __device__ __forceinline__ int ph_lo() const { return ((__attribute__((address_space(4))) const int*)ka)[62]; }
    __device__ __forceinline__ int ph_hi() const { return ((__attribute__((address_space(4))) const int*)ka)[63]; }
};
static_assert(sizeof(Params) == 256, "Params layout");

enum { I_X = 0, I_C, I_CTX, I_CCTX, I_MODW, I_MODB, I_FFNIN, I_FFNOUT, I_WIN, I_WOUT, I_CONVW, I_CONVB, I_DTB, I_ALOG, I_AD, I_ANORM,
       I_LRE, I_LIM, I_LSTEP, I_BRE, I_BIM, I_CRE, I_CIM, I_S5D, I_GLUW, I_GLUB, I_HGLB, I_HGNORM, I_FNORM };

__device__ __forceinline__ float bf_lo(unsigned w) { return __builtin_bit_cast(float, w << 16); }
__device__ __forceinline__ float bf_hi(unsigned w) { return __builtin_bit_cast(float, w & 0xffff0000u); }
__device__ __forceinline__ float bf1(bf16_t h) { return __builtin_bit_cast(float, (unsigned)h << 16); }
typedef __bf16 bf16x2_t __attribute__((ext_vector_type(2)));
__device__ __forceinline__ unsigned pkbf(float lo, float hi) { const f32x2 v = {lo, hi}; const bf16x2_t b = __builtin_convertvector(v, bf16x2_t); return __builtin_bit_cast(unsigned, b); }
__device__ __forceinline__ float frcp(float x) { return __builtin_amdgcn_rcpf(x); }
__device__ __forceinline__ float sigmoidf_(float x) { return frcp(1.0f + __expf(-x)); }
__device__ __forceinline__ float siluf_(float x) { return x * sigmoidf_(x); }
template <int CTRL> __device__ __forceinline__ float dpp_f(float v) {
    return __builtin_bit_cast(float, __builtin_amdgcn_update_dpp(0, __builtin_bit_cast(int, v), CTRL, 0xf, 0xf, true));
}
__device__ __forceinline__ float row16_sum(float v) {
    v += dpp_f<0xB1>(v); v += dpp_f<0x4E>(v); v += dpp_f<0x141>(v); v += dpp_f<0x140>(v); return v;
}
__device__ __forceinline__ float wave_sum(float v, int lane) {
    v = row16_sum(v);
    v += __builtin_bit_cast(float, __builtin_amdgcn_ds_bpermute((lane ^ 16) << 2, __builtin_bit_cast(int, v)));
    v += __builtin_bit_cast(float, __builtin_amdgcn_ds_bpermute((lane ^ 32) << 2, __builtin_bit_cast(int, v)));
    return v;
}
__device__ __forceinline__ void unpack8(const u32x4 w, float* f) {
    f[0] = bf_lo(w.x); f[1] = bf_hi(w.x); f[2] = bf_lo(w.y); f[3] = bf_hi(w.y); f[4] = bf_lo(w.z); f[5] = bf_hi(w.z); f[6] = bf_lo(w.w); f[7] = bf_hi(w.w);
}

#define XB_TMO      128
#define XB_XCNT(j)  (256  + 64 * (j))
#define XB_XSUB(j)  (1280 + 64 * (j))
#define XB_XGEN(j)  (2304 + 64 * (j))
#define XB_TOP      3328
#define XB_TOPGEN   3392
#define XCD_BAR_WORDS 3456
#define XB_SPIN_CAP (1u << 18)

__device__ __forceinline__ unsigned xb_ld(unsigned* p)              { return __hip_atomic_load(p, __ATOMIC_RELAXED, __HIP_MEMORY_SCOPE_AGENT); }
__device__ __forceinline__ unsigned xb_add(unsigned* p, unsigned v) { return __hip_atomic_fetch_add(p, v, __ATOMIC_RELAXED, __HIP_MEMORY_SCOPE_AGENT); }
__device__ __forceinline__ unsigned xb_xcc_id() { return (unsigned)__builtin_amdgcn_s_getreg((3 << 11) | 20) & 0xFu; }
#define XB_SPIN(cond, bar) do { unsigned _sp = 0; while (cond) { __builtin_amdgcn_s_sleep(1); \
    if ((++_sp & 255u) == 0u) { if (xb_ld(&(bar)[XB_TMO])) break; if (_sp > XB_SPIN_CAP) { atomicAdd(&(bar)[XB_TMO], 1u); break; } } } } while (0)

struct XcdBarrier {
    unsigned* bar; unsigned x;
    volatile LAS unsigned* st;
};

__device__ __forceinline__ XcdBarrier xcd_barrier_post(unsigned* bar, volatile LAS unsigned* st, int tid) {
    XcdBarrier b; b.bar = bar; b.x = xb_xcc_id(); b.st = st;
    if (tid == 0) (void)xb_add(&bar[XB_XCNT(b.x)], 1u);
    return b;
}
__device__ __forceinline__ void xcd_barrier_complete(unsigned* bar, unsigned x, unsigned& nloc, unsigned& nx) {
    const unsigned G = gridDim.x * gridDim.y * gridDim.z;
    unsigned sum, cnt, mine, sp = 0u;
    for (;;) {
        sum = 0u; cnt = 0u; mine = 0u;
#pragma unroll
        for (unsigned j = 0; j < 16; ++j) { const unsigned c = xb_ld(&bar[XB_XCNT(j)]); sum += c; cnt += (c > 0u) ? 1u : 0u; mine = (j == x) ? c : mine; }
        if (sum == G) break;
        __builtin_amdgcn_s_sleep(1);
        if ((++sp & 255u) == 0u) { if (xb_ld(&bar[XB_TMO])) break; if (sp > XB_SPIN_CAP) { atomicAdd(&bar[XB_TMO], 1u); break; } }
    }
    nloc = mine > 0u ? mine : 1u; nx = cnt > 0u ? cnt : 1u;
}

__device__ __forceinline__ void xcd_barrier(const XcdBarrier& b, int tid) {
    asm volatile("s_waitcnt vmcnt(0)" ::: "memory");
    __syncthreads();
    if (tid == 0) {
        unsigned* bar = b.bar;
        __builtin_amdgcn_s_waitcnt(0);
        unsigned nloc = b.st[0], nx = b.st[1];
        if (nloc == 0u) { xcd_barrier_complete(bar, b.x, nloc, nx); b.st[0] = nloc; b.st[1] = nx; }
        const unsigned old = xb_add(&bar[XB_XSUB(b.x)], 1u);
        const unsigned gen = old / nloc;
        if (old + 1u == (gen + 1u) * nloc) {
            __builtin_amdgcn_fence(__ATOMIC_RELEASE, "agent");
            asm volatile("s_waitcnt vmcnt(0)" ::: "memory");
            const unsigned og = xb_add(&bar[XB_TOP], 1u);
            const unsigned tg = og / nx;
            if (og + 1u == (tg + 1u) * nx) xb_add(&bar[XB_TOPGEN], 1u);
            else XB_SPIN(xb_ld(&bar[XB_TOPGEN]) == tg, bar);
            __builtin_amdgcn_fence(__ATOMIC_ACQUIRE, "agent");
            xb_add(&bar[XB_XGEN(b.x)], 1u);
            asm volatile("s_waitcnt vmcnt(0)" ::: "memory");
        } else {
            XB_SPIN(xb_ld(&bar[XB_XGEN(b.x)]) == gen, bar);
            __builtin_amdgcn_fence(__ATOMIC_ACQUIRE, "agent");
            asm volatile("s_waitcnt vmcnt(0)" ::: "memory");
        }
    }
    __syncthreads();
}

namespace pg8 {
__device__ __forceinline__ float row_rstd(const float* SS, size_t row) {
    const f32x4 a = *(const f32x4*)(SS + row * 16), b = *(const f32x4*)(SS + row * 16 + 4), c = *(const f32x4*)(SS + row * 16 + 8), d = *(const f32x4*)(SS + row * 16 + 12);
    const f32x4 s = (a + b) + (c + d);
    return rsqrtf(((s.x + s.y) + (s.z + s.w)) * (1.0f / 1024.0f) + 1e-6f);
}
struct EpiSwiglu {
    static constexpr bool PERM = true, AFTER_DRAIN = false;
    bf16_t* O; PG8_LAS unsigned char* RS; const float* bias;
    __device__ __forceinline__ void operator()(const f32x4 (&acc)[2][2][4][2], const Unit& u, int wr, int wc, int fr, int fq, int ui) const {
        asm volatile("" : "+v"(fr), "+v"(fq));
        const int row0 = u.pm * BM + wr * 64 + fr, col0 = u.pn * 128 + wc * 32 + 8 * fq;
        const int mrow = u.pm < 256 ? (u.pm >> 3) : 32;
        const float* bg = bias + (size_t)mrow * 5632 + u.pn * BM + wc * 32 + 8 * fq;
        const f32x4 bg0 = *(const f32x4*)bg, bg1 = *(const f32x4*)(bg + 4), bu0 = *(const f32x4*)(bg + 128), bu1 = *(const f32x4*)(bg + 132);
#pragma unroll
        for (int ai = 0; ai < 2; ++ai)
#pragma unroll
            for (int m = 0; m < 4; ++m) {
                const size_t row = (size_t)(row0 + ai * HALF + m * 16);
                const float rs = ((const PG8_LAS float*)RS)[ui * 256 + wr * 64 + fr + ai * HALF + m * 16];
                bf16_t* rowp = O + row * 2816 + col0;
                float v[8];
#pragma unroll
                for (int n = 0; n < 2; ++n)
#pragma unroll
                    for (int j = 0; j < 4; ++j) { const float g = acc[ai][0][m][n][j] * rs + (n ? bg1[j] : bg0[j]), up = acc[ai][1][m][n][j] * rs + (n ? bu1[j] : bu0[j]); v[n * 4 + j] = g * __builtin_amdgcn_rcpf(1.0f + __expf(-g)) * up; }
                u32x4 w; w.x = cvt_pk_bf16(v[0], v[1]); w.y = cvt_pk_bf16(v[2], v[3]); w.z = cvt_pk_bf16(v[4], v[5]); w.w = cvt_pk_bf16(v[6], v[7]);
                *(u32x4*)rowp = w;
            }
    }
};
struct EpiP {
    static constexpr bool PERM = true, AFTER_DRAIN = false;
    bf16_t* O; int ldc; int nvalid; PG8_LAS unsigned char* RS; const float* bias;
    __device__ __forceinline__ void operator()(const f32x4 (&acc)[2][2][4][2], const Unit& u, int wr, int wc, int fr, int fq, int ui) const {
        asm volatile("" : "+v"(fr), "+v"(fq));
        const int row0 = u.pm * BM + wr * 64 + fr;
        const int mrow = u.pm < 256 ? (u.pm >> 3) : 32;
        float rs[2][4];
#pragma unroll
        for (int ai = 0; ai < 2; ++ai)
#pragma unroll
            for (int m = 0; m < 4; ++m) rs[ai][m] = ((const PG8_LAS float*)RS)[ui * 256 + wr * 64 + fr + ai * HALF + m * 16];
#pragma unroll
        for (int bj = 0; bj < 2; ++bj) {
            const int col = u.pn * BM + bj * HALF + wc * 32 + 8 * fq;
            if (col < nvalid) {
                const f32x4 b0 = *(const f32x4*)(bias + (size_t)mrow * 5632 + col), b1 = *(const f32x4*)(bias + (size_t)mrow * 5632 + col + 4);
#pragma unroll
                for (int ai = 0; ai < 2; ++ai)
#pragma unroll
                    for (int m = 0; m < 4; ++m) {
                        const f32x4 v0 = acc[ai][bj][m][0] * rs[ai][m] + b0, v1 = acc[ai][bj][m][1] * rs[ai][m] + b1;
                        u32x4 w; w.x = cvt_pk_bf16(v0[0], v0[1]); w.y = cvt_pk_bf16(v0[2], v0[3]); w.z = cvt_pk_bf16(v1[0], v1[1]); w.w = cvt_pk_bf16(v1[2], v1[3]);
                        *(u32x4*)(O + (size_t)(row0 + ai * HALF + m * 16) * ldc + col) = w;
                    }
            }
        }
    }
};
struct EpiResid {
    static constexpr bool PERM = true, AFTER_DRAIN = false;
    kaptr_t ka; int l, q;
    __device__ __forceinline__ void operator()(const f32x4 (&acc)[2][2][4][2], const Unit& u, int wr, int wc, int fr, int fq, int ui) const {
        asm volatile("" : "+v"(fr), "+v"(fq));
        kaptr_t k2 = ka; asm volatile("" : "+s"(k2));
        const KP P{k2};
        unsigned char* ws = P.ws();
        const bool first = (l == 0 && q == 1);
        float* hctx = (float*)(ws + WS_HCTX);
        const float* srcLat = first ? P.in(I_X) : P.out(); const float* srcCtx = first ? P.in(I_CTX) : hctx; float* dstLat = P.out(); float* dstCtx = hctx;
        const float* modl = (const float*)(ws + WS_MOD) + (size_t)l * 33 * MODW;
        const int midx = q == 1 ? 2 : (q == 7 ? 5 : 8); const float coef = q == 7 ? 1.0f : 0.5f;
        bf16_t* xs = (bf16_t*)(ws + (q == 7 ? WS_YF : WS_U)); float* SS = (float*)(ws + WS_SS);
        const float* nscale = q == 1 ? modl + 4 * DM : (q == 7 ? modl + 7 * DM : (l == 0 ? modl + (size_t)33 * MODW + 1 * DM : nullptr));
        const bool lat = u.pm < (MLAT / BM);
        const int mrow = lat ? (u.pm >> 3) : 32;
        const float* mv = modl + (size_t)mrow * MODW + midx * DM;
        const size_t rbase = (size_t)(lat ? u.pm : u.pm - MLAT / BM) * BM + wr * 64 + fr;
        const size_t grow = (size_t)u.pm * BM + wr * 64 + fr;
        const float* src = lat ? srcLat : srcCtx; float* dst = lat ? dstLat : dstCtx;
        float ss[2][4];
#pragma unroll
        for (int ai = 0; ai < 2; ++ai)
#pragma unroll
            for (int m = 0; m < 4; ++m) ss[ai][m] = 0.f;
#pragma unroll
        for (int bj = 0; bj < 2; ++bj) {
            const int c = u.pn * BM + bj * HALF + wc * 32 + 8 * fq;
            const f32x4 mm0 = *(const f32x4*)(mv + c) * coef, mm1 = *(const f32x4*)(mv + c + 4) * coef;
            f32x4 sc0 = (f32x4){1.f, 1.f, 1.f, 1.f}, sc1 = sc0;
            if (nscale) { sc0 = *(const f32x4*)(nscale + (size_t)mrow * MODW + c) + 1.0f; sc1 = *(const f32x4*)(nscale + (size_t)mrow * MODW + c + 4) + 1.0f; }
#pragma unroll
            for (int ai = 0; ai < 2; ++ai)
#pragma unroll
                for (int m = 0; m < 4; ++m) {
                    const size_t off = (rbase + ai * HALF + m * 16) * DM + c;
                    const f32x4 h0 = *(const f32x4*)(src + off) + mm0 * acc[ai][bj][m][0], h1 = *(const f32x4*)(src + off + 4) + mm1 * acc[ai][bj][m][1];
                    *(f32x4*)(dst + off) = h0; *(f32x4*)(dst + off + 4) = h1;
                    if (nscale) {
                        ss[ai][m] += ((h0.x * h0.x + h0.y * h0.y) + (h0.z * h0.z + h0.w * h0.w)) + ((h1.x * h1.x + h1.y * h1.y) + (h1.z * h1.z + h1.w * h1.w));
                        const f32x4 x0 = h0 * sc0, x1 = h1 * sc1;
                        u32x4 w; w.x = cvt_pk_bf16(x0.x, x0.y); w.y = cvt_pk_bf16(x0.z, x0.w); w.z = cvt_pk_bf16(x1.x, x1.y); w.w = cvt_pk_bf16(x1.z, x1.w);
                        *(u32x4*)(xs + (grow + ai * HALF + m * 16) * DM + c) = w;
                    }
                }
        }
        if (nscale) {
            const int lane = fr + 16 * fq;
#pragma unroll
            for (int ai = 0; ai < 2; ++ai)
#pragma unroll
                for (int m = 0; m < 4; ++m) {
                    float s = ss[ai][m];
                    s += __builtin_bit_cast(float, __builtin_amdgcn_ds_bpermute((lane ^ 16) << 2, __builtin_bit_cast(int, s)));
                    s += __builtin_bit_cast(float, __builtin_amdgcn_ds_bpermute((lane ^ 32) << 2, __builtin_bit_cast(int, s)));
                    if (fq == 0) SS[(grow + ai * HALF + m * 16) * 16 + u.pn * 4 + wc] = s;
                }
        }
    }
};
struct EpiGlu {
    static constexpr bool PERM = true, AFTER_DRAIN = false;
    const bf16_t* Y; bf16_t* mix; const float* gb;
    __device__ __forceinline__ void operator()(const f32x4 (&acc)[2][2][4][2], const Unit& u, int wr, int wc, int fr, int fq, int ui) const {
        asm volatile("" : "+v"(fr), "+v"(fq));
        const int row0 = u.pm * BM + wr * 64 + fr;
#pragma unroll
        for (int bj = 0; bj < 2; ++bj) {
            const int col = bj * HALF + wc * 32 + 8 * fq;
            const f32x4 b0 = *(const f32x4*)(gb + col), b1 = *(const f32x4*)(gb + col + 4);
#pragma unroll
            for (int ai = 0; ai < 2; ++ai)
#pragma unroll
                for (int m = 0; m < 4; ++m) {
                    const size_t row = (size_t)(row0 + ai * HALF + m * 16);
                    const u32x4 yw = *(const u32x4*)(Y + row * 256 + col);
                    const f32x4 v0 = acc[ai][bj][m][0] + b0, v1 = acc[ai][bj][m][1] + b1;
                    float y[8]; y[0] = __builtin_bit_cast(float, yw.x << 16); y[1] = __builtin_bit_cast(float, yw.x & 0xffff0000u); y[2] = __builtin_bit_cast(float, yw.y << 16); y[3] = __builtin_bit_cast(float, yw.y & 0xffff0000u);
                    y[4] = __builtin_bit_cast(float, yw.z << 16); y[5] = __builtin_bit_cast(float, yw.z & 0xffff0000u); y[6] = __builtin_bit_cast(float, yw.w << 16); y[7] = __builtin_bit_cast(float, yw.w & 0xffff0000u);
                    float o[8];
#pragma unroll
                    for (int j = 0; j < 4; ++j) { o[j] = y[j] * __builtin_amdgcn_rcpf(1.0f + __expf(-v0[j])); o[4 + j] = y[4 + j] * __builtin_amdgcn_rcpf(1.0f + __expf(-v1[j])); }
                    u32x4 w; w.x = cvt_pk_bf16(o[0], o[1]); w.y = cvt_pk_bf16(o[2], o[3]); w.z = cvt_pk_bf16(o[4], o[5]); w.w = cvt_pk_bf16(o[6], o[7]);
                    *(u32x4*)(mix + row * DM + 512 + col) = w;
                }
        }
    }
};
}
__device__ __forceinline__ void cvt_item(const float* src, int ldsrc, int scol0, int nvalid, bf16_t* dst, int lddst, LAS float* scr, int lane) {
    f32x4 v[8];
#pragma unroll
    for (int i = 0; i < 8; ++i) { const int kk = i * 8 + (lane >> 3), n4 = (lane & 7) * 4; v[i] = (n4 < nvalid) ? *(const f32x4*)(src + (size_t)kk * ldsrc + scol0 + n4) : (f32x4){0.f, 0.f, 0.f, 0.f}; }
#pragma unroll
    for (int i = 0; i < 8; ++i) { const int kk = i * 8 + (lane >> 3), n4 = (lane & 7) * 4; LAS float* s = scr + kk * 33 + n4; s[0] = v[i].x; s[1] = v[i].y; s[2] = v[i].z; s[3] = v[i].w; }
    const int c = lane & 7;
#pragma unroll
    for (int j = 0; j < 4; ++j) { const int n = (lane >> 3) + 8 * j; const LAS float* s = scr + (8 * c) * 33 + n;
        u32x4 o; o.x = pkbf(s[0], s[33]); o.y = pkbf(s[66], s[99]); o.z = pkbf(s[132], s[165]); o.w = pkbf(s[198], s[231]);
        *(u32x4*)(dst + (size_t)n * lddst + 8 * c) = o; }
}

__device__ __forceinline__ void prologue_phase(const KP P, LAS unsigned char* lds, int tid, int wid, int lane, int bid) {
    const int gw = bid * 8 + wid, nw = (int)gridDim.x * 8;
    {
    LAS float* scr = (LAS float*)(lds + 135168 + wid * 1024);
    (void)scr;
    }
    LAS float* scr = (LAS float*)(lds + wid * 16384);
    constexpr int PER_LAYER = 2 * 5264;
    for (int it = gw; it < 2 * PER_LAYER; it += nw) {
        const int l = it / PER_LAYER; int r = it - l * PER_LAYER;
        unsigned char* wl = P.ws() + WS_W + (size_t)l * W_LAYER;
        const float* src; int ldsrc, K, scol0, nvalid = 32, kt, nt; bf16_t* dst;
        if (r < 5632) { const int j = r / 2816; r -= j * 2816; kt = r / 176; nt = r - kt * 176;
            src = P.in(I_FFNIN) + (size_t)(l * 2 + j) * DM * (2 * DFF); ldsrc = 2 * DFF; K = DM;
            const int n0 = nt * 32, pn = n0 >> 8, bj = (n0 >> 7) & 1, i0 = n0 & 127; scol0 = bj * DFF + pn * 128 + i0;
            dst = (bf16_t*)(wl + WO_FI + (size_t)j * FI_BYTES); }
        else if (r < 8448) { r -= 5632; const int j = r / 1408; r -= j * 1408; kt = r / 32; nt = r - kt * 32;
            src = P.in(I_FFNOUT) + (size_t)(l * 2 + j) * DFF * DM; ldsrc = DM; K = DFF; scol0 = nt * 32;
            dst = (bf16_t*)(wl + WO_FO + (size_t)j * FO_BYTES); }
        else if (r < 9984) { r -= 8448; kt = r / 96; nt = r - kt * 96;
            src = P.in(I_WIN) + (size_t)l * DM * INC; ldsrc = INC; K = DM; scol0 = nt * 32; nvalid = INC - nt * 32;
            dst = (bf16_t*)(wl + WO_WIN); }
        else if (r < 10496) { r -= 9984; kt = r / 32; nt = r - kt * 32;
            src = P.in(I_WOUT) + (size_t)l * DM * DM; ldsrc = DM; K = DM; scol0 = nt * 32;
            dst = (bf16_t*)(wl + WO_WOUT); }
        else { r -= 10496; kt = r / 8; nt = r - kt * 8;
            src = P.in(I_GLUW) + (size_t)l * 65536; ldsrc = 256; K = 256; scol0 = nt * 32;
            dst = (bf16_t*)(wl + WO_GLU); }
        cvt_item(src + (size_t)kt * 64 * ldsrc, ldsrc, scol0, nvalid, dst + (size_t)nt * 32 * K + kt * 64, K, scr, lane);
    }
    __syncthreads();
    LAS float* sc = (LAS float*)lds;
    for (int i = tid; i < 33 * DM; i += NTHREADS) { const int bb = i >> 10, k = i & 1023; const float v = bb < 32 ? P.in(I_C)[bb * DM + k] : P.in(I_CCTX)[k]; sc[i] = siluf_(v); }
    __syncthreads();
    float* part = (float*)(P.ws() + WS_MODP);
    for (int it = gw; it < 2 * 144 * 8; it += nw) {
        const int l = it / 1152, r = it - l * 1152, jc = r >> 3, ks = r & 7, col = jc * 64 + lane;
        const float* W = P.in(I_MODW) + (size_t)l * DM * MODW + (size_t)(ks * 128) * MODW + col;
        float acc[33];
#pragma unroll
        for (int q = 0; q < 33; ++q) acc[q] = 0.f;
#pragma unroll 2
        for (int k8 = 0; k8 < 16; ++k8) {
            float w[8];
#pragma unroll
            for (int e = 0; e < 8; ++e) w[e] = W[(size_t)(8 * k8 + e) * MODW];
#pragma unroll
            for (int q = 0; q < 33; ++q) {
                const f32x4 s0 = *(const LAS f32x4*)(sc + q * DM + ks * 128 + 8 * k8), s1 = *(const LAS f32x4*)(sc + q * DM + ks * 128 + 8 * k8 + 4);
                acc[q] += (s0.x * w[0] + s0.y * w[1]) + (s0.z * w[2] + s0.w * w[3]) + (s1.x * w[4] + s1.y * w[5]) + (s1.z * w[6] + s1.w * w[7]);
            }
        }
#pragma unroll
        for (int q = 0; q < 33; ++q) part[((size_t)(l * 8 + ks) * 33 + q) * MODW + col] = acc[q];
    }
    __syncthreads();
}
__device__ __forceinline__ void modreduce_phase(const KP P, int gtid, int nthr) {
    const float* part = (const float*)(P.ws() + WS_MODP); float* modo = (float*)(P.ws() + WS_MOD);
    for (int i = gtid; i < 2 * 33 * MODW / 4; i += nthr) {
        const int e = i * 4, l = e / (33 * MODW), r = e - l * 33 * MODW, col = r % MODW;
        f32x4 a = *(const f32x4*)(P.in(I_MODB) + l * MODW + col);
#pragma unroll
        for (int ks = 0; ks < 8; ++ks) a += *(const f32x4*)(part + (size_t)(l * 8 + ks) * 33 * MODW + r);
        *(f32x4*)(modo + e) = a;
    }
    if (gtid < 512) {
        float* lbt = (float*)(P.ws() + WS_LB);
        lbt[gtid] = frcp(1.0f + __expf(P.in(I_HGLB)[gtid] - P.in(I_HGLB)[512 + gtid]));
    }
}

__device__ __forceinline__ void norm_phase(const float* hlat, const float* hctx, const float* modl, int ish, int isc, bf16_t* u, int nrows, int gw, int nw, int lane) {
    for (int row = gw; row < nrows; row += nw) {
        const float* src = row < MLAT ? hlat + (size_t)row * DM : hctx + (size_t)(row - MLAT) * DM;
        const int mrow = row < MLAT ? (row >> 11) : 32;
        const float* sh = modl + (size_t)mrow * MODW + ish * DM; const float* sl = modl + (size_t)mrow * MODW + isc * DM;
        f32x4 v[4]; float ss = 0.f;
#pragma unroll
        for (int i = 0; i < 2; ++i) { v[2 * i] = *(const f32x4*)(src + lane * 8 + 512 * i); v[2 * i + 1] = *(const f32x4*)(src + lane * 8 + 512 * i + 4); }
#pragma unroll
        for (int i = 0; i < 4; ++i) ss += (v[i].x * v[i].x + v[i].y * v[i].y) + (v[i].z * v[i].z + v[i].w * v[i].w);
        const float rstd = rsqrtf(wave_sum(ss, lane) * (1.0f / DM) + EPS);
#pragma unroll
        for (int i = 0; i < 2; ++i) {
            const int c = lane * 8 + 512 * i;
            const f32x4 s0 = *(const f32x4*)(sl + c), s1 = *(const f32x4*)(sl + c + 4), h0 = *(const f32x4*)(sh + c), h1 = *(const f32x4*)(sh + c + 4);
            const f32x4 a = v[2 * i] * rstd * (s0 + 1.0f) + h0, b = v[2 * i + 1] * rstd * (s1 + 1.0f) + h1;
            u32x4 w; w.x = pkbf(a.x, a.y); w.y = pkbf(a.z, a.w); w.z = pkbf(b.x, b.y); w.w = pkbf(b.z, b.w);
            *(u32x4*)(u + (size_t)row * DM + c) = w;
        }
    }
}
__device__ __forceinline__ void prep_phase(const KP P, LAS unsigned char* lds, int tid, int gw, int nw, int lane) {
    const float* mod0 = (const float*)(P.ws() + WS_MOD);
    bf16_t* xs = (bf16_t*)(P.ws() + WS_U); float* SS = (float*)(P.ws() + WS_SS);
    for (int row0 = gw; row0 < MALL; row0 += 2 * nw) {
        f32x4 v[2][4]; bool has[2]; int rw[2];
#pragma unroll
        for (int r = 0; r < 2; ++r) { const int rr = row0 + r * nw; has[r] = rr < MALL; rw[r] = has[r] ? rr : row0;
            const float* src = rw[r] < MLAT ? P.in(I_X) + (size_t)rw[r] * DM : P.in(I_CTX) + (size_t)(rw[r] - MLAT) * DM;
#pragma unroll
            for (int i = 0; i < 2; ++i) { v[r][2 * i] = *(const f32x4*)(src + lane * 8 + 512 * i); v[r][2 * i + 1] = *(const f32x4*)(src + lane * 8 + 512 * i + 4); } }
        __builtin_amdgcn_sched_barrier(0);
#pragma unroll
        for (int r = 0; r < 2; ++r) {
            const int row = rw[r];
            const int mrow = row < MLAT ? (row >> 11) : 32;
            const float* sl = mod0 + (size_t)mrow * MODW + 1 * DM;
            float ss = 0.f;
#pragma unroll
            for (int i = 0; i < 2; ++i) {
                const int c = lane * 8 + 512 * i;
                const f32x4 v0 = v[r][2 * i], v1 = v[r][2 * i + 1], s0 = *(const f32x4*)(sl + c) + 1.0f, s1 = *(const f32x4*)(sl + c + 4) + 1.0f;
                ss += (v0.x * v0.x + v0.y * v0.y) + (v0.z * v0.z + v0.w * v0.w) + (v1.x * v1.x + v1.y * v1.y) + (v1.z * v1.z + v1.w * v1.w);
                const f32x4 a = v0 * s0, b = v1 * s1;
                u32x4 w; w.x = pkbf(a.x, a.y); w.y = pkbf(a.z, a.w); w.z = pkbf(b.x, b.y); w.w = pkbf(b.z, b.w);
                if (has[r]) *(u32x4*)(xs + (size_t)row * DM + c) = w;
            }
            ss = wave_sum(ss, lane);
            if (has[r] && lane < 4) *(f32x4*)(SS + (size_t)row * 16 + lane * 4) = (f32x4){lane == 0 ? ss : 0.f, 0.f, 0.f, 0.f};
        }
    }
    LAS float* sh = (LAS float*)lds;
    float* BT = (float*)(P.ws() + WS_BIAS);
    const int wid = tid >> 6;
    for (int lt = 0; lt < 6; ++lt) {
        const int l = lt / 3, t = lt - 3 * l, N = t == 1 ? INCP : 2 * DFF;
        const float* modl = mod0 + (size_t)l * 33 * MODW + (3 * t) * DM;
        __syncthreads();
        for (int i = tid; i < 33 * DM; i += NTHREADS) sh[i] = modl[(size_t)(i >> 10) * MODW + (i & 1023)];
        __syncthreads();
        const bf16_t* Bt = (const bf16_t*)(P.ws() + WS_W + (size_t)l * W_LAYER + (t == 0 ? WO_FI : (t == 1 ? WO_WIN : WO_FI + FI_BYTES)));
        float* out = BT + (size_t)lt * BIAS_TAB;
        for (int n = blockIdx.x * 8 + wid; n < N; n += nw) {
            float w[16];
            unpack8(*(const u32x4*)(Bt + (size_t)n * DM + lane * 16), w); unpack8(*(const u32x4*)(Bt + (size_t)n * DM + lane * 16 + 8), w + 8);
            float keep = 0.f;
#pragma unroll 1
            for (int q = 0; q < 33; ++q) {
                const LAS float* s = sh + q * DM + lane * 16;
                const f32x4 a = *(const LAS f32x4*)s, b = *(const LAS f32x4*)(s + 4), c = *(const LAS f32x4*)(s + 8), d = *(const LAS f32x4*)(s + 12);
                float acc = (a.x * w[0] + a.y * w[1]) + (a.z * w[2] + a.w * w[3]) + (b.x * w[4] + b.y * w[5]) + (b.z * w[6] + b.w * w[7])
                          + (c.x * w[8] + c.y * w[9]) + (c.z * w[10] + c.w * w[11]) + (d.x * w[12] + d.y * w[13]) + (d.z * w[14] + d.w * w[15]);
                acc = wave_sum(acc, lane);
                if (lane == q) keep = acc;
            }
            if (lane < 33) out[(size_t)lane * BIAS_LD + n] = keep;
        }
    }
    __syncthreads();
}

template <class Sched> __device__ __forceinline__ void rstd_prestep(const Sched& S, const float* SS, LAS unsigned char* lds, int tid) {
    LAS float* R = (LAS float*)(lds + 131072);
    pg8::Unit u;
    for (int i = 0; S.next(i, u); ++i) if (tid < 256) R[i * 256 + tid] = pg8::row_rstd(SS, (size_t)u.pm * 256 + tid);
    __syncthreads();
}

__device__ __forceinline__ void final_phase(float* out, const float* fw, int gw, int nw, int lane) {
    f32x4 w[4];
#pragma unroll
    for (int i = 0; i < 4; ++i) w[i] = *(const f32x4*)(fw + lane * 4 + 256 * i);
    for (int row = gw; row < MLAT; row += 3 * nw) {
        f32x4 v[3][4]; bool has[3];
#pragma unroll
        for (int r = 0; r < 3; ++r) { const int rr = row + r * nw; has[r] = rr < MLAT; const float* src = out + (size_t)(has[r] ? rr : row) * DM;
#pragma unroll
            for (int i = 0; i < 4; ++i) v[r][i] = *(const f32x4*)(src + lane * 4 + 256 * i); }
        __builtin_amdgcn_sched_barrier(0);
#pragma unroll
        for (int r = 0; r < 3; ++r) {
            float ss = 0.f;
#pragma unroll
            for (int i = 0; i < 4; ++i) ss += (v[r][i].x * v[r][i].x + v[r][i].y * v[r][i].y) + (v[r][i].z * v[r][i].z + v[r][i].w * v[r][i].w);
            const float rstd = rsqrtf(wave_sum(ss, lane) * (1.0f / DM) + EPS);
            if (has[r]) { float* dst = out + (size_t)(row + r * nw) * DM;
#pragma unroll
                for (int i = 0; i < 4; ++i) *(f32x4*)(dst + lane * 4 + 256 * i) = v[r][i] * rstd * w[i]; }
        }
    }
}

struct ConvIn { u32x4 x[5]; };
__device__ __forceinline__ ConvIn conv_load(const bf16_t* p, int row, int ch, bool colmajor) {
    ConvIn r;
    const bool lat = row < MLAT;
    int s, L, base;
    if (lat) { const int tok = row & 2047; s = colmajor ? ((tok & 63) * 32 + (tok >> 6)) : tok; L = SEQ; base = row & ~2047; }
    else { const int r2 = row - MLAT; s = r2 & 255; L = CTXL; base = MLAT + (r2 & ~255); }
#pragma unroll
    for (int d = 0; d < 5; ++d) {
        const int sp = s + d - 2;
        r.x[d] = (u32x4){0u, 0u, 0u, 0u};
        if (sp >= 0 && sp < L) { const int tokp = (lat && colmajor) ? ((sp & 31) * 64 + (sp >> 5)) : sp; r.x[d] = *(const u32x4*)(p + (size_t)(base + tokp) * INC + PC_XBC + ch); }
    }
    return r;
}
__device__ __forceinline__ void conv_item(const ConvIn& r, bf16_t* cv, const float* cw, const float* cb, int row, int ch) {
    float acc[8];
    { const f32x4 b0 = *(const f32x4*)(cb + ch), b1 = *(const f32x4*)(cb + ch + 4); acc[0] = b0.x; acc[1] = b0.y; acc[2] = b0.z; acc[3] = b0.w; acc[4] = b1.x; acc[5] = b1.y; acc[6] = b1.z; acc[7] = b1.w; }
#pragma unroll
    for (int d = 0; d < 5; ++d) {
        float xf[8]; unpack8(r.x[d], xf);
        const f32x4 w0 = *(const f32x4*)(cw + d * 768 + ch), w1 = *(const f32x4*)(cw + d * 768 + ch + 4);
        acc[0] += w0.x * xf[0]; acc[1] += w0.y * xf[1]; acc[2] += w0.z * xf[2]; acc[3] += w0.w * xf[3];
        acc[4] += w1.x * xf[4]; acc[5] += w1.y * xf[5]; acc[6] += w1.z * xf[6]; acc[7] += w1.w * xf[7];
    }
    u32x4 w; w.x = pkbf(siluf_(acc[0]), siluf_(acc[1])); w.y = pkbf(siluf_(acc[2]), siluf_(acc[3])); w.z = pkbf(siluf_(acc[4]), siluf_(acc[5])); w.w = pkbf(siluf_(acc[6]), siluf_(acc[7]));
    *(u32x4*)(cv + (size_t)row * 768 + ch) = w;
}
__device__ __forceinline__ void conv_phase(const bf16_t* p, bf16_t* cv, const float* cw, const float* cb, bool colmajor, int gtid, int nthr) {
    for (int idx = gtid; idx < MALL * 96; idx += 4 * nthr) {
        ConvIn in[4]; int row[4], ch[4]; bool has[4];
#pragma unroll
        for (int r = 0; r < 4; ++r) { const int i = idx + r * nthr; has[r] = i < MALL * 96; const int j = has[r] ? i : idx; row[r] = j / 96; ch[r] = (j - row[r] * 96) * 8; in[r] = conv_load(p, row[r], ch[r], colmajor); }
        __builtin_amdgcn_sched_barrier(0);
#pragma unroll
        for (int r = 0; r < 4; ++r) if (has[r]) conv_item(in[r], cv, cw, cb, row[r], ch[r]);
    }
}

__device__ __forceinline__ int seq_row(int b, int dir, int i, bool colmajor) {
    if (i < CTXL) { const int s = dir ? (CTXL - 1 - i) : i; return MLAT + b * CTXL + s; }
    int s = i - CTXL; if (dir) s = SEQ - 1 - s;
    const int tok = colmajor ? ((s & 31) * 64 + (s >> 5)) : s;
    return b * SEQ + tok;
}

template <bool HG>
__device__ __forceinline__ void scan_mat(const KP P, int l, int un, LAS float* wl, int lane) {
    int b, dir, h, half;
    if (!HG) { b = un >> 5; dir = (un >> 4) & 1; h = (un >> 1) & 7; half = un & 1; }
    else { b = un >> 4; dir = (un >> 3) & 1; h = (un >> 1) & 3; half = un & 1; }
    const bool colmajor = (l & 1) != 0;
    const bf16_t* p = (const bf16_t*)(P.ws() + WS_P); const bf16_t* cv = (const bf16_t*)(P.ws() + WS_U);
    bf16_t* Y = (bf16_t*)(P.ws() + (dir ? WS_YB : WS_YF));
    LAS float* Fb = wl; LAS float* Bb = wl + 1024; LAS float* Cb = wl + 2048; LAS float* Xb = wl + 3072; LAS float* Ob = wl + 3584;
    const int si = lane >> 2, part = lane & 3, pg = lane >> 3, ng = lane & 7;
    float dtb = 0.f, aneg = 0.f, dsk = 0.f; float oml[16];
    if (!HG) { dtb = P.in(I_DTB)[(l * 2 + dir) * 8 + h]; aneg = -__expf(P.in(I_ALOG)[(l * 2 + dir) * 8 + h]); dsk = dir == 0 ? P.in(I_AD)[l * 8 + h] : 0.f; }
#pragma unroll
    for (int j = 0; j < 16; ++j) {
        float lb = 0.f;
        if (HG && l == 1) { const int idx = dir * 256 + h * 64 + part * 16 + j; lb = frcp(1.0f + __expf(P.in(I_HGLB)[idx] - P.in(I_HGLB)[512 + idx])); }
        oml[j] = 1.0f - lb;
    }
    const int colbase = HG ? (768 + h * 64 + half * 32 + part * 8) : (h * 64 + half * 32 + part * 8);
    f32x2 S[4][4];
#pragma unroll
    for (int a = 0; a < 4; ++a)
#pragma unroll
        for (int c = 0; c < 4; ++c) S[a][c] = (f32x2){0.f, 0.f};
    u32x4 r0, r1, r2, r3, r4; bf16_t rdt = 0; int rown;
#define SCAN_LOAD(ch) do { rown = seq_row(b, dir, (ch) * 16 + si, colmajor); \
        if (!HG) { const bf16_t* cr = cv + (size_t)rown * 768; r0 = *(const u32x4*)(cr + h * 64 + half * 32 + part * 8); \
            r1 = *(const u32x4*)(cr + 512 + (h >> 2) * 64 + part * 16); r2 = *(const u32x4*)(cr + 512 + (h >> 2) * 64 + part * 16 + 8); \
            r3 = *(const u32x4*)(cr + 640 + (h >> 2) * 64 + part * 16); r4 = *(const u32x4*)(cr + 640 + (h >> 2) * 64 + part * 16 + 8); \
            rdt = p[(size_t)rown * INC + PC_DT + dir * 8 + h]; } \
        else { const bf16_t* pr = p + (size_t)rown * INC; r0 = *(const u32x4*)(pr + PC_I + h * 64 + half * 32 + part * 8); \
            r1 = *(const u32x4*)(pr + PC_F + dir * 256 + h * 64 + part * 16); r2 = *(const u32x4*)(pr + PC_F + dir * 256 + h * 64 + part * 16 + 8); \
            r3 = *(const u32x4*)(pr + PC_Q + h * 64 + part * 16); r4 = *(const u32x4*)(pr + PC_Q + h * 64 + part * 16 + 8); } } while (0)
    SCAN_LOAD(0);
    for (int ch = 0; ch < NSTEP / 16; ++ch) {
        const int rowc = rown;
        {
            float t[16];
            unpack8(r0, t);
            *(LAS f32x4*)(Xb + si * 32 + part * 8) = (f32x4){t[0], t[1], t[2], t[3]}; *(LAS f32x4*)(Xb + si * 32 + part * 8 + 4) = (f32x4){t[4], t[5], t[6], t[7]};
            unpack8(r1, t); unpack8(r2, t + 8);
            if (!HG) {
#pragma unroll
                for (int q = 0; q < 4; ++q) *(LAS f32x4*)(Bb + si * 64 + part * 16 + 4 * q) = (f32x4){t[4 * q], t[4 * q + 1], t[4 * q + 2], t[4 * q + 3]};
                if (part == 0) { const float xr = bf1(rdt) + dtb; const float dt = fmaxf(xr, 0.f) + log1pf(__expf(-fabsf(xr))); *(LAS f32x2*)(Fb + si * 64) = (f32x2){__expf(dt * aneg), dt}; }
            } else {
                float kk[16], ff[16];
#pragma unroll
                for (int j = 0; j < 16; ++j) { kk[j] = oml[j] * frcp(1.0f + __expf(t[j])); ff[j] = 1.0f - kk[j]; }
#pragma unroll
                for (int q = 0; q < 4; ++q) { *(LAS f32x4*)(Bb + si * 64 + part * 16 + 4 * q) = (f32x4){kk[4 * q], kk[4 * q + 1], kk[4 * q + 2], kk[4 * q + 3]};
                    *(LAS f32x4*)(Fb + si * 64 + part * 16 + 4 * q) = (f32x4){ff[4 * q], ff[4 * q + 1], ff[4 * q + 2], ff[4 * q + 3]}; }
            }
            unpack8(r3, t); unpack8(r4, t + 8);
            if (HG) {
#pragma unroll
                for (int j = 0; j < 16; ++j) t[j] = siluf_(t[j]);
            }
#pragma unroll
            for (int q = 0; q < 4; ++q) *(LAS f32x4*)(Cb + si * 64 + part * 16 + 4 * q) = (f32x4){t[4 * q], t[4 * q + 1], t[4 * q + 2], t[4 * q + 3]};
        }
        if (ch + 1 < NSTEP / 16) SCAN_LOAD(ch + 1);
#pragma unroll 2
        for (int s = 0; s < 16; ++s) {
            const f32x4 x4 = *(const LAS f32x4*)(Xb + s * 32 + pg * 4);
            const f32x4 b0 = *(const LAS f32x4*)(Bb + s * 64 + ng * 8), b1 = *(const LAS f32x4*)(Bb + s * 64 + ng * 8 + 4);
            const f32x4 c0 = *(const LAS f32x4*)(Cb + s * 64 + ng * 8), c1 = *(const LAS f32x4*)(Cb + s * 64 + ng * 8 + 4);
            f32x2 fv[4]; f32x4 xs = x4;
            if (!HG) { const f32x2 dd = *(const LAS f32x2*)(Fb + s * 64); fv[0] = fv[1] = fv[2] = fv[3] = (f32x2){dd.x, dd.x}; xs = x4 * dd.y; }
            else { const f32x4 f0 = *(const LAS f32x4*)(Fb + s * 64 + ng * 8), f1 = *(const LAS f32x4*)(Fb + s * 64 + ng * 8 + 4);
                fv[0] = (f32x2){f0.x, f0.y}; fv[1] = (f32x2){f0.z, f0.w}; fv[2] = (f32x2){f1.x, f1.y}; fv[3] = (f32x2){f1.z, f1.w}; }
            const f32x2 bv[4] = {(f32x2){b0.x, b0.y}, (f32x2){b0.z, b0.w}, (f32x2){b1.x, b1.y}, (f32x2){b1.z, b1.w}};
            const f32x2 cq[4] = {(f32x2){c0.x, c0.y}, (f32x2){c0.z, c0.w}, (f32x2){c1.x, c1.y}, (f32x2){c1.z, c1.w}};
            float y[4];
#pragma unroll
            for (int pi = 0; pi < 4; ++pi) {
                const f32x2 xx = (f32x2){xs[pi], xs[pi]};
                f32x2 a2 = (f32x2){0.f, 0.f};
#pragma unroll
                for (int q = 0; q < 4; ++q) { S[pi][q] = fv[q] * S[pi][q] + xx * bv[q]; a2 += S[pi][q] * cq[q]; }
                float yy = a2.x + a2.y;
                yy += dpp_f<0xB1>(yy); yy += dpp_f<0x4E>(yy); yy += dpp_f<0x141>(yy);
                y[pi] = yy;
            }
            if (ng == 0) { f32x4 yo = (f32x4){y[0], y[1], y[2], y[3]}; if (!HG) yo += x4 * dsk; *(LAS f32x4*)(Ob + s * 32 + pg * 4) = yo; }
        }
        {
            const f32x4 o0 = *(const LAS f32x4*)(Ob + si * 32 + part * 8), o1 = *(const LAS f32x4*)(Ob + si * 32 + part * 8 + 4);
            u32x4 w; w.x = pkbf(o0.x, o0.y); w.y = pkbf(o0.z, o0.w); w.z = pkbf(o1.x, o1.y); w.w = pkbf(o1.z, o1.w);
            *(u32x4*)(Y + (size_t)rowc * DM + colbase) = w;
        }
    }
#undef SCAN_LOAD
}

__device__ __forceinline__ bf16x8 as_bf8(u32x4 v) { return __builtin_bit_cast(bf16x8, v); }
__device__ __forceinline__ void ssd_mfma_unit(const KP P, int l, int un, LAS unsigned char* wlb, int lane) {
    const int b = un >> 5, dir = (un >> 4) & 1, h = (un >> 1) & 7, half = un & 1, g = h >> 2;
    const bool colmajor = (l & 1) != 0;
    const bf16_t* p = (const bf16_t*)(P.ws() + WS_P); const bf16_t* cv = (const bf16_t*)(P.ws() + WS_U);
    bf16_t* Y = (bf16_t*)(P.ws() + (dir ? WS_YB : WS_YF));
    LAS bf16_t* XL = (LAS bf16_t*)wlb;
    LAS bf16_t* BL = (LAS bf16_t*)(wlb + 4096);
    LAS bf16_t* SL = (LAS bf16_t*)(wlb + 12288);
    LAS float* cumL = (LAS float*)(wlb + 20992); LAS float* dtL = cumL + 64; LAS float* wL = cumL + 128;
    const int li = lane & 15, quad = lane >> 4;
    const float dtb = P.in(I_DTB)[(l * 2 + dir) * 8 + h], aneg = -__expf(P.in(I_ALOG)[(l * 2 + dir) * 8 + h]), dsk = dir == 0 ? P.in(I_AD)[l * 8 + h] : 0.f;
    f32x4 Sacc[2][4];
#pragma unroll
    for (int a = 0; a < 2; ++a)
#pragma unroll
        for (int c = 0; c < 4; ++c) Sacc[a][c] = (f32x4){0.f, 0.f, 0.f, 0.f};
    for (int i = lane; i < 32 * 136 / 2; i += 64) ((LAS unsigned*)SL)[i] = 0u;
    const int ycol = h * 64 + half * 32;
    asm volatile("" ::: "memory");
    bf16_t rdt; u32x4 xq[4]; u32x4 fB[4][2], fC[4][2]; int rr[4];
#define SSD_LOAD_A(ch) do { const int rt_ = seq_row(b, dir, (ch) * 64 + lane, colmajor); rdt = p[(size_t)rt_ * INC + PC_DT + dir * 8 + h]; \
        const bf16_t* xrow_ = cv + (size_t)rt_ * 768 + ycol; _Pragma("unroll") for (int q = 0; q < 4; ++q) xq[q] = *(const u32x4*)(xrow_ + q * 8); } while (0)
#define SSD_LOAD_B(ch) do { _Pragma("unroll") for (int t = 0; t < 4; ++t) { rr[t] = seq_row(b, dir, (ch) * 64 + 16 * t + li, colmajor); \
        _Pragma("unroll") for (int ks = 0; ks < 2; ++ks) { const bf16_t* cr_ = cv + (size_t)rr[t] * 768 + g * 64 + 32 * ks + quad * 8; fB[t][ks] = *(const u32x4*)(cr_ + 512); fC[t][ks] = *(const u32x4*)(cr_ + 640); } } } while (0)
    SSD_LOAD_A(0); SSD_LOAD_B(0);
#pragma unroll 1
    for (int ch = 0; ch < NSTEP / 64; ++ch) {
        {
            const float xr = bf1(rdt) + dtb;
            const float dt = fmaxf(xr, 0.f) + log1pf(__expf(-fabsf(xr)));
            float cum = dt * aneg;
#pragma unroll
            for (int o = 1; o < 64; o <<= 1) { const float t = __builtin_bit_cast(float, __builtin_amdgcn_ds_bpermute((lane - o) << 2, __builtin_bit_cast(int, cum))); if (lane >= o) cum += t; }
            const float cum63 = __builtin_bit_cast(float, __builtin_amdgcn_readlane(__builtin_bit_cast(int, cum), 63));
            cumL[lane] = cum; dtL[lane] = dt; wL[lane] = __expf(cum63 - cum) * dt;
#pragma unroll
            for (int q = 0; q < 4; ++q) *(LAS u32x4*)(XL + lane * 32 + q * 8) = xq[q];
            const float dall = __expf(cum63);
#pragma unroll
            for (int a = 0; a < 2; ++a)
#pragma unroll
                for (int c = 0; c < 4; ++c) Sacc[a][c] = Sacc[a][c] * dall;
        }
#pragma unroll
        for (int t = 0; t < 4; ++t)
#pragma unroll
            for (int ks = 0; ks < 2; ++ks) *(LAS u32x4*)(BL + (16 * t + li) * 64 + 32 * ks + quad * 8) = fB[t][ks];
        asm volatile("" ::: "memory");
        float ci[4];
#pragma unroll
        for (int it = 0; it < 4; ++it) ci[it] = cumL[16 * it + li];
        __builtin_amdgcn_sched_barrier(0);
        u32x4 Mf[4][2];
#pragma unroll
        for (int it = 0; it < 4; ++it) { Mf[it][0] = (u32x4){0u, 0u, 0u, 0u}; Mf[it][1] = (u32x4){0u, 0u, 0u, 0u}; }
        const bool needY = !(l == 1 && ch < CTXL / 64);
        if (needY)
#pragma unroll
        for (int jt = 0; jt < 4; ++jt) {
            const f32x4 cj = *(const LAS f32x4*)(cumL + 16 * jt + quad * 4), dj = *(const LAS f32x4*)(dtL + 16 * jt + quad * 4);
#pragma unroll
            for (int it = jt; it < 4; ++it) {
                f32x4 acc = (f32x4){0.f, 0.f, 0.f, 0.f};
                acc = __builtin_amdgcn_mfma_f32_16x16x32_bf16(as_bf8(fB[jt][0]), as_bf8(fC[it][0]), acc, 0, 0, 0);
                acc = __builtin_amdgcn_mfma_f32_16x16x32_bf16(as_bf8(fB[jt][1]), as_bf8(fC[it][1]), acc, 0, 0, 0);
                float v[4];
#pragma unroll
                for (int jj = 0; jj < 4; ++jj) {
                    float m = acc[jj] * __expf(ci[it] - cj[jj]) * dj[jj];
                    if (jt == it && (quad * 4 + jj) > li) m = 0.f;
                    v[jj] = m;
                }
                const unsigned lo = pkbf(v[0], v[1]), hi = pkbf(v[2], v[3]);
                if (jt & 1) { Mf[it][jt >> 1].z = lo; Mf[it][jt >> 1].w = hi; } else { Mf[it][jt >> 1].x = lo; Mf[it][jt >> 1].y = hi; }
            }
        }
        unsigned xg[2][2][8]; u32x4 Sf[2][2];
#pragma unroll
        for (int pt = 0; pt < 2; ++pt)
#pragma unroll
            for (int ks2 = 0; ks2 < 2; ++ks2)
#pragma unroll
                for (int e = 0; e < 8; ++e) xg[pt][ks2][e] = XL[(32 * ks2 + 16 * (e >> 2) + quad * 4 + (e & 3)) * 32 + 16 * pt + li];
#pragma unroll
        for (int pt = 0; pt < 2; ++pt)
#pragma unroll
            for (int ks = 0; ks < 2; ++ks) Sf[pt][ks] = *(const LAS u32x4*)(SL + (16 * pt + li) * 136 + 32 * ks + quad * 8);
        __builtin_amdgcn_sched_barrier(0);
        u32x4 XT[2][2];
#pragma unroll
        for (int pt = 0; pt < 2; ++pt)
#pragma unroll
            for (int ks2 = 0; ks2 < 2; ++ks2)
                XT[pt][ks2] = (u32x4){xg[pt][ks2][0] | (xg[pt][ks2][1] << 16), xg[pt][ks2][2] | (xg[pt][ks2][3] << 16), xg[pt][ks2][4] | (xg[pt][ks2][5] << 16), xg[pt][ks2][6] | (xg[pt][ks2][7] << 16)};
        if (needY)
#pragma unroll
        for (int it = 0; it < 4; ++it) {
            const float eci = __expf(ci[it]);
#pragma unroll
            for (int pt = 0; pt < 2; ++pt) {
                f32x4 acc = (f32x4){0.f, 0.f, 0.f, 0.f}, acc2 = (f32x4){0.f, 0.f, 0.f, 0.f};
#pragma unroll
                for (int ks2 = 0; ks2 < 2; ++ks2) if (2 * ks2 <= it) acc = __builtin_amdgcn_mfma_f32_16x16x32_bf16(as_bf8(XT[pt][ks2]), as_bf8(Mf[it][ks2]), acc, 0, 0, 0);
#pragma unroll
                for (int ks = 0; ks < 2; ++ks) acc2 = __builtin_amdgcn_mfma_f32_16x16x32_bf16(as_bf8(Sf[pt][ks]), as_bf8(fC[it][ks]), acc2, 0, 0, 0);
                const u32x2 xw = *(const LAS u32x2*)(XL + (16 * it + li) * 32 + 16 * pt + quad * 4);
                acc = acc + acc2 * eci;
                acc[0] += dsk * bf_lo(xw.x); acc[1] += dsk * bf_hi(xw.x); acc[2] += dsk * bf_lo(xw.y); acc[3] += dsk * bf_hi(xw.y);
                u32x2 o; o.x = pkbf(acc[0], acc[1]); o.y = pkbf(acc[2], acc[3]);
                *(u32x2*)(Y + (size_t)rr[it] * DM + ycol + 16 * pt + quad * 4) = o;
            }
        }
        if (ch + 1 < NSTEP / 64) { SSD_LOAD_A(ch + 1); SSD_LOAD_B(ch + 1); }
        f32x4 w0[2], w1[2];
#pragma unroll
        for (int ks2 = 0; ks2 < 2; ++ks2) { w0[ks2] = *(const LAS f32x4*)(wL + 32 * ks2 + quad * 4); w1[ks2] = *(const LAS f32x4*)(wL + 32 * ks2 + 16 + quad * 4); }
#pragma unroll
        for (int nh = 0; nh < 2; ++nh) {
            unsigned bg[2][2][8];
#pragma unroll
            for (int n2 = 0; n2 < 2; ++n2)
#pragma unroll
                for (int ks2 = 0; ks2 < 2; ++ks2)
#pragma unroll
                    for (int e = 0; e < 8; ++e) bg[n2][ks2][e] = BL[(32 * ks2 + 16 * (e >> 2) + quad * 4 + (e & 3)) * 64 + 16 * (2 * nh + n2) + li];
            __builtin_amdgcn_sched_barrier(0);
#pragma unroll
            for (int n2 = 0; n2 < 2; ++n2)
#pragma unroll
                for (int ks2 = 0; ks2 < 2; ++ks2) {
                    float v[8];
#pragma unroll
                    for (int e = 0; e < 8; ++e) v[e] = __builtin_bit_cast(float, bg[n2][ks2][e] << 16) * ((e < 4) ? w0[ks2][e & 3] : w1[ks2][e & 3]);
                    const u32x4 bw = (u32x4){pkbf(v[0], v[1]), pkbf(v[2], v[3]), pkbf(v[4], v[5]), pkbf(v[6], v[7])};
#pragma unroll
                    for (int pt = 0; pt < 2; ++pt) Sacc[pt][2 * nh + n2] = __builtin_amdgcn_mfma_f32_16x16x32_bf16(as_bf8(XT[pt][ks2]), as_bf8(bw), Sacc[pt][2 * nh + n2], 0, 0, 0);
                }
            __builtin_amdgcn_sched_barrier(0);
        }
#pragma unroll
        for (int pt = 0; pt < 2; ++pt)
#pragma unroll
            for (int nt = 0; nt < 4; ++nt) {
                const unsigned s01 = pkbf(Sacc[pt][nt][0], Sacc[pt][nt][1]), s23 = pkbf(Sacc[pt][nt][2], Sacc[pt][nt][3]);
                LAS bf16_t* sp = SL + (16 * pt + quad * 4) * 136 + 16 * nt + li;
                sp[0] = (bf16_t)(s01 & 0xffffu); sp[136] = (bf16_t)(s01 >> 16); sp[272] = (bf16_t)(s23 & 0xffffu); sp[408] = (bf16_t)(s23 >> 16);
            }
        asm volatile("" ::: "memory");
    }
#undef SSD_LOAD_A
#undef SSD_LOAD_B
}

__device__ __forceinline__ void hg_prepass(const KP P, int l, int gw, int nw, int lane) {
    bf16_t* p = (bf16_t*)(P.ws() + WS_P); bf16_t* qb = (bf16_t*)(P.ws() + WS_YBUF); float* E15 = (float*)(P.ws() + WS_MODP);
    const float* lbt = (const float*)(P.ws() + WS_LB);
    const bool colmajor = (l & 1) != 0;
    const int li = lane & 15, quad = lane >> 4;
    for (int it = gw; it < 32 * 144 * 4; it += nw) {
        const int h = it & 3, r = it >> 2, b = r / 144, blk = r - b * 144;
        const int row = seq_row(b, 0, blk * 16 + li, colmajor);
        bf16_t* pr = p + (size_t)row * INC;
        u32x4 rq[2], rf[2], rb[2];
#pragma unroll
        for (int ks = 0; ks < 2; ++ks) { rq[ks] = *(const u32x4*)(pr + PC_Q + h * 64 + 32 * ks + quad * 8); rf[ks] = *(const u32x4*)(pr + PC_F + h * 64 + 32 * ks + quad * 8); rb[ks] = *(const u32x4*)(pr + PC_F + 256 + h * 64 + 32 * ks + quad * 8); }
        float omf[16], omb[16];
#pragma unroll
        for (int ks = 0; ks < 2; ++ks)
#pragma unroll
            for (int q4 = 0; q4 < 2; ++q4) {
                f32x4 a = (f32x4){0.f, 0.f, 0.f, 0.f}, c = a;
                if (l == 1) { a = *(const f32x4*)(lbt + h * 64 + 32 * ks + quad * 8 + 4 * q4); c = *(const f32x4*)(lbt + 256 + h * 64 + 32 * ks + quad * 8 + 4 * q4); }
#pragma unroll
                for (int j = 0; j < 4; ++j) { omf[8 * ks + 4 * q4 + j] = 1.0f - a[j]; omb[8 * ks + 4 * q4 + j] = 1.0f - c[j]; }
            }
        float qv[16], zf[16], zb[16];
        unpack8(rq[0], qv); unpack8(rq[1], qv + 8); unpack8(rf[0], zf); unpack8(rf[1], zf + 8); unpack8(rb[0], zb); unpack8(rb[1], zb + 8);
        float qf[16], kf[16], qbw[16], kb[16], ef[16], eb[16];
#pragma unroll
        for (int i = 0; i < 16; ++i) {
            const float sq = siluf_(qv[i]);
            {
                const float kk = omf[i] * frcp(1.0f + __expf(zf[i]));
                float L = __logf(1.0f - kk);
                L += dpp_f<0x111>(L); L += dpp_f<0x112>(L); L += dpp_f<0x114>(L); L += dpp_f<0x118>(L);
                L = fmaxf(L, -60.0f);
                const float eL = __expf(L);
                qf[i] = sq * eL; kf[i] = kk * frcp(eL); ef[i] = eL;
            }
            {
                const float kk = omb[i] * frcp(1.0f + __expf(zb[i]));
                float L = __logf(1.0f - kk);
                L += dpp_f<0x101>(L); L += dpp_f<0x102>(L); L += dpp_f<0x104>(L); L += dpp_f<0x108>(L);
                L = fmaxf(L, -60.0f);
                const float eL = __expf(L);
                qbw[i] = sq * eL; kb[i] = kk * frcp(eL); eb[i] = eL;
            }
        }
        bf16_t* qbr = qb + (size_t)row * 256;
#pragma unroll
        for (int ks = 0; ks < 2; ++ks) {
            const int o = 8 * ks;
            *(u32x4*)(pr + PC_Q + h * 64 + 32 * ks + quad * 8) = (u32x4){pkbf(qf[o], qf[o + 1]), pkbf(qf[o + 2], qf[o + 3]), pkbf(qf[o + 4], qf[o + 5]), pkbf(qf[o + 6], qf[o + 7])};
            *(u32x4*)(pr + PC_F + h * 64 + 32 * ks + quad * 8) = (u32x4){pkbf(kf[o], kf[o + 1]), pkbf(kf[o + 2], kf[o + 3]), pkbf(kf[o + 4], kf[o + 5]), pkbf(kf[o + 6], kf[o + 7])};
            *(u32x4*)(pr + PC_F + 256 + h * 64 + 32 * ks + quad * 8) = (u32x4){pkbf(kb[o], kb[o + 1]), pkbf(kb[o + 2], kb[o + 3]), pkbf(kb[o + 4], kb[o + 5]), pkbf(kb[o + 6], kb[o + 7])};
            *(u32x4*)(qbr + h * 64 + 32 * ks + quad * 8) = (u32x4){pkbf(qbw[o], qbw[o + 1]), pkbf(qbw[o + 2], qbw[o + 3]), pkbf(qbw[o + 4], qbw[o + 5]), pkbf(qbw[o + 6], qbw[o + 7])};
        }
        if (li == 15) { float* e = E15 + ((size_t)(0 * 32 + b) * 144 + blk) * 256 + h * 64 + quad * 8;
#pragma unroll
            for (int ks = 0; ks < 2; ++ks) { *(f32x4*)(e + 32 * ks) = (f32x4){ef[8 * ks], ef[8 * ks + 1], ef[8 * ks + 2], ef[8 * ks + 3]}; *(f32x4*)(e + 32 * ks + 4) = (f32x4){ef[8 * ks + 4], ef[8 * ks + 5], ef[8 * ks + 6], ef[8 * ks + 7]}; } }
        if (li == 0) { float* e = E15 + ((size_t)(1 * 32 + b) * 144 + blk) * 256 + h * 64 + quad * 8;
#pragma unroll
            for (int ks = 0; ks < 2; ++ks) { *(f32x4*)(e + 32 * ks) = (f32x4){eb[8 * ks], eb[8 * ks + 1], eb[8 * ks + 2], eb[8 * ks + 3]}; *(f32x4*)(e + 32 * ks + 4) = (f32x4){eb[8 * ks + 4], eb[8 * ks + 5], eb[8 * ks + 6], eb[8 * ks + 7]}; } }
    }
}

__device__ __forceinline__ void hg_mfma_unit(const KP P, int l, int un, LAS unsigned char* wlb, int lane) {
    const int b = un >> 4, dir = (un >> 3) & 1, h = (un >> 1) & 3, vhalf = un & 1;
    const bool colmajor = (l & 1) != 0;
    const bf16_t* p = (const bf16_t*)(P.ws() + WS_P); const bf16_t* qb = (const bf16_t*)(P.ws() + WS_YBUF); const float* E15 = (const float*)(P.ws() + WS_MODP);
    bf16_t* Y = (bf16_t*)(P.ws() + (dir ? WS_YB : WS_YF));
    LAS bf16_t* VL = (LAS bf16_t*)wlb;
    LAS bf16_t* KL = (LAS bf16_t*)(wlb + 1024);
    LAS bf16_t* SL = (LAS bf16_t*)(wlb + 3072);
    const int li = lane & 15, quad = lane >> 4;
    f32x4 Sacc[2][4];
#pragma unroll
    for (int a = 0; a < 2; ++a)
#pragma unroll
        for (int c = 0; c < 4; ++c) Sacc[a][c] = (f32x4){0.f, 0.f, 0.f, 0.f};
    for (int i = lane; i < 32 * 72 / 2; i += 64) ((LAS unsigned*)SL)[i] = 0u;
    asm volatile("" ::: "memory");
    const int ycol = 768 + h * 64 + vhalf * 32;
    u32x4 KfA[4][2], QfA[4][2], rvA[4]; float e15A[4][4]; int rownA[4];
#define HG_LOAD(ch, k) do { rownA[k] = seq_row(b, dir, (ch) * 16 + li, colmajor); const bf16_t* pr = p + (size_t)rownA[k] * INC; \
        const bf16_t* qs = dir ? qb + (size_t)rownA[k] * 256 + h * 64 + quad * 8 : pr + PC_Q + h * 64 + quad * 8; \
        KfA[k][0] = *(const u32x4*)(pr + PC_F + dir * 256 + h * 64 + quad * 8); KfA[k][1] = *(const u32x4*)(pr + PC_F + dir * 256 + h * 64 + 32 + quad * 8); \
        QfA[k][0] = *(const u32x4*)(qs); QfA[k][1] = *(const u32x4*)(qs + 32); \
        rvA[k] = *(const u32x4*)(pr + PC_I + h * 64 + vhalf * 32 + quad * 8); \
        const int blk_ = dir ? ((ch) < 16 ? 15 - (ch) : 159 - (ch)) : (ch); const float* ep = E15 + ((size_t)(dir * 32 + b) * 144 + blk_) * 256 + h * 64 + li; \
        e15A[k][0] = ep[0]; e15A[k][1] = ep[16]; e15A[k][2] = ep[32]; e15A[k][3] = ep[48]; } while (0)
#pragma unroll
    for (int k = 0; k < 4; ++k) HG_LOAD(k, k);
#pragma unroll 1
    for (int ch0 = 0; ch0 < NSTEP / 16; ch0 += 4) {
#pragma unroll
      for (int k = 0; k < 4; ++k) {
        const int ch = ch0 + k;
        const int rowc = rownA[k];
        const u32x4 Kc0 = KfA[k][0], Kc1 = KfA[k][1], Qc0 = QfA[k][0], Qc1 = QfA[k][1], rv = rvA[k];
        const float ec0 = e15A[k][0], ec1 = e15A[k][1], ec2 = e15A[k][2], ec3 = e15A[k][3];
        *(LAS u32x4*)(VL + li * 32 + quad * 8) = rv;
        *(LAS u32x4*)(KL + li * 64 + quad * 8) = Kc0; *(LAS u32x4*)(KL + li * 64 + 32 + quad * 8) = Kc1;
        if (ch + 4 < NSTEP / 16) HG_LOAD(ch + 4, k);
        asm volatile("" ::: "memory");
        unsigned va[2][4], ka4[4][4]; u32x4 Sf[2][2];
#pragma unroll
        for (int vt = 0; vt < 2; ++vt) { const LAS bf16_t* vp = VL + (quad * 4) * 32 + 16 * vt + li; va[vt][0] = vp[0]; va[vt][1] = vp[32]; va[vt][2] = vp[64]; va[vt][3] = vp[96]; }
#pragma unroll
        for (int kt4 = 0; kt4 < 4; ++kt4) { const LAS bf16_t* kp = KL + (quad * 4) * 64 + 16 * kt4 + li; ka4[kt4][0] = kp[0]; ka4[kt4][1] = kp[64]; ka4[kt4][2] = kp[128]; ka4[kt4][3] = kp[192]; }
#pragma unroll
        for (int vt = 0; vt < 2; ++vt) { Sf[vt][0] = *(const LAS u32x4*)(SL + (16 * vt + li) * 72 + quad * 8); Sf[vt][1] = *(const LAS u32x4*)(SL + (16 * vt + li) * 72 + 32 + quad * 8); }
        __builtin_amdgcn_sched_barrier(0);
        const bool needY = !(l == 1 && ch < CTXL / 16);
        u32x4 Af = (u32x4){0u, 0u, 0u, 0u};
        if (needY) {
            f32x4 acc = (f32x4){0.f, 0.f, 0.f, 0.f};
            acc = __builtin_amdgcn_mfma_f32_16x16x32_bf16(as_bf8(Kc0), as_bf8(Qc0), acc, 0, 0, 0);
            acc = __builtin_amdgcn_mfma_f32_16x16x32_bf16(as_bf8(Kc1), as_bf8(Qc1), acc, 0, 0, 0);
#pragma unroll
            for (int jj = 0; jj < 4; ++jj) if (quad * 4 + jj > li) acc[jj] = 0.f;
            Af = (u32x4){pkbf(acc[0], acc[1]), pkbf(acc[2], acc[3]), 0u, 0u};
        }
        u32x4 VT[2];
#pragma unroll
        for (int vt = 0; vt < 2; ++vt) VT[vt] = (u32x4){va[vt][0] | (va[vt][1] << 16), va[vt][2] | (va[vt][3] << 16), 0u, 0u};
        if (needY)
#pragma unroll
        for (int vt = 0; vt < 2; ++vt) {
            f32x4 acc = (f32x4){0.f, 0.f, 0.f, 0.f};
            acc = __builtin_amdgcn_mfma_f32_16x16x32_bf16(as_bf8(VT[vt]), as_bf8(Af), acc, 0, 0, 0);
            acc = __builtin_amdgcn_mfma_f32_16x16x32_bf16(as_bf8(Sf[vt][0]), as_bf8(Qc0), acc, 0, 0, 0);
            acc = __builtin_amdgcn_mfma_f32_16x16x32_bf16(as_bf8(Sf[vt][1]), as_bf8(Qc1), acc, 0, 0, 0);
            u32x2 o; o.x = pkbf(acc[0], acc[1]); o.y = pkbf(acc[2], acc[3]);
            *(u32x2*)(Y + (size_t)rowc * DM + ycol + 16 * vt + quad * 4) = o;
        }
#pragma unroll
        for (int kt4 = 0; kt4 < 4; ++kt4) {
            const u32x4 kT = (u32x4){ka4[kt4][0] | (ka4[kt4][1] << 16), ka4[kt4][2] | (ka4[kt4][3] << 16), 0u, 0u};
            const float e = kt4 == 0 ? ec0 : (kt4 == 1 ? ec1 : (kt4 == 2 ? ec2 : ec3));
#pragma unroll
            for (int vt = 0; vt < 2; ++vt) {
                Sacc[vt][kt4] = __builtin_amdgcn_mfma_f32_16x16x32_bf16(as_bf8(VT[vt]), as_bf8(kT), Sacc[vt][kt4], 0, 0, 0);
                Sacc[vt][kt4] = Sacc[vt][kt4] * e;
                const unsigned s01 = pkbf(Sacc[vt][kt4][0], Sacc[vt][kt4][1]), s23 = pkbf(Sacc[vt][kt4][2], Sacc[vt][kt4][3]);
                LAS bf16_t* sp = SL + (16 * vt + quad * 4) * 72 + 16 * kt4 + li;
                sp[0] = (bf16_t)(s01 & 0xffffu); sp[72] = (bf16_t)(s01 >> 16); sp[144] = (bf16_t)(s23 & 0xffffu); sp[216] = (bf16_t)(s23 >> 16);
            }
        }
        asm volatile("" ::: "memory");
      }
    }
#undef HG_LOAD
}

__device__ __forceinline__ void s5_coef(float lre, float lim, float stp, float& ar, float& ai, float& kr, float& ki) {
    const float mag = __expf(lre * stp);
    float ang = lim * stp; { const float kq = rintf(ang * 0.15915494309f); ang = fmaf(-kq, 6.2831855f, ang); ang = fmaf(-kq, -1.7484555e-7f, ang); }
    float sn, cs; sincosf(ang, &sn, &cs);
    ar = mag * cs; ai = mag * sn;
    const float den = lre * lre + lim * lim, nr = ar - 1.0f; kr = (nr * lre + ai * lim) / den; ki = (ai * lre - nr * lim) / den;
}
__device__ __forceinline__ void s5_unit(const KP P, int l, int b, int dir, int g, LAS float* wl, int lane) {
    const bool colmajor = (l & 1) != 0;
    const bf16_t* p = (const bf16_t*)(P.ws() + WS_P);
    bf16_t* Y = (bf16_t*)(P.ws() + (dir ? WS_YB : WS_YF));
    LAS float* Ub = wl; LAS int* Rb = (LAS int*)(wl + 256); LAS bf16_t* XB = (LAS bf16_t*)(wl + 512);
    LAS float* VLs = wl + 1600;
    const int idx = (l * 2 + dir) * 16 + g, n = lane, li = lane & 15, c = lane & 15, quad = lane >> 4;
    const float stp = __expf(P.in(I_LSTEP)[idx]);
    float ar, ai;
    { float kr_, ki_; s5_coef(P.in(I_LRE)[idx * 64 + n], P.in(I_LIM)[idx * 64 + n], stp, ar, ai, kr_, ki_); }
    u32x4 Btf[8];
#pragma unroll
    for (int T = 0; T < 4; ++T) {
        const int n2 = 16 * T + li;
        float ar2, ai2, kr, ki; s5_coef(P.in(I_LRE)[idx * 64 + n2], P.in(I_LIM)[idx * 64 + n2], stp, ar2, ai2, kr, ki);
        u32x4 wr = (u32x4){0u, 0u, 0u, 0u}, wi = wr;
        if (quad < 2) {
            const float* br = P.in(I_BRE) + (size_t)(idx * 64 + n2) * 16 + quad * 8; const float* bi = P.in(I_BIM) + (size_t)(idx * 64 + n2) * 16 + quad * 8;
            const f32x4 r0 = *(const f32x4*)br, r1 = *(const f32x4*)(br + 4), i0 = *(const f32x4*)bi, i1 = *(const f32x4*)(bi + 4);
            const f32x4 a0 = r0 * kr - i0 * ki, a1 = r1 * kr - i1 * ki, b0 = i0 * kr + r0 * ki, b1 = i1 * kr + r1 * ki;
            wr = (u32x4){pkbf(a0.x, a0.y), pkbf(a0.z, a0.w), pkbf(a1.x, a1.y), pkbf(a1.z, a1.w)};
            wi = (u32x4){pkbf(b0.x, b0.y), pkbf(b0.z, b0.w), pkbf(b1.x, b1.y), pkbf(b1.z, b1.w)};
        }
        Btf[T] = wr; Btf[T + 4] = wi;
    }
    bf16x8 Cop[4];
#pragma unroll
    for (int kk = 0; kk < 4; ++kk) {
        const float* srcp = (kk < 2 ? P.in(I_CRE) : P.in(I_CIM)) + (size_t)(idx * 16 + c) * 64 + (kk & 1) * 32 + quad * 8;
        const f32x4 v0 = *(const f32x4*)srcp, v1 = *(const f32x4*)(srcp + 4);
        const float sg = kk < 2 ? 1.0f : -1.0f;
        u32x4 w; w.x = pkbf(sg * v0.x, sg * v0.y); w.y = pkbf(sg * v0.z, sg * v0.w); w.z = pkbf(sg * v1.x, sg * v1.y); w.w = pkbf(sg * v1.z, sg * v1.w);
        Cop[kk] = __builtin_bit_cast(bf16x8, w);
    }
    const float dsk = dir == 0 ? P.in(I_S5D)[l * 256 + g * 16 + c] : 0.f;
    float xr = 0.f, xi = 0.f;
    u32x4 ruA[4]; int rownA[4];
#pragma unroll
    for (int k = 0; k < 4; ++k) ruA[k] = (u32x4){0u, 0u, 0u, 0u};
#define S5_LOAD(ch, k) do { rownA[k] = seq_row(b, dir, (ch) * 16 + li, colmajor); if (quad < 2) ruA[k] = *(const u32x4*)(p + (size_t)rownA[k] * INC + PC_S5 + g * 16 + quad * 8); } while (0)
#pragma unroll
    for (int k = 0; k < 4; ++k) S5_LOAD(k, k);
#pragma unroll 1
    for (int ch0 = 0; ch0 < NSTEP / 16; ch0 += 4) {
#pragma unroll
      for (int k = 0; k < 4; ++k) {
        const int ch = ch0 + k;
        const u32x4 uc = ruA[k]; const int rown = rownA[k];
        if (quad < 2) { float t[8]; unpack8(uc, t); *(LAS f32x4*)(Ub + li * 16 + quad * 8) = (f32x4){t[0], t[1], t[2], t[3]}; *(LAS f32x4*)(Ub + li * 16 + quad * 8 + 4) = (f32x4){t[4], t[5], t[6], t[7]}; }
        if (quad == 0) Rb[li] = rown;
        if (ch + 4 < NSTEP / 16) S5_LOAD(ch + 4, k);
#pragma unroll
        for (int T = 0; T < 8; ++T) {
            const f32x4 acc = __builtin_amdgcn_mfma_f32_16x16x32_bf16(as_bf8(uc), as_bf8(Btf[T]), (f32x4){0.f, 0.f, 0.f, 0.f}, 0, 0, 0);
            *(LAS f32x4*)(VLs + (16 * T + li) * 20 + quad * 4) = acc;
        }
        asm volatile("" ::: "memory");
        f32x4 vr4[4], vi4[4];
#pragma unroll
        for (int q = 0; q < 4; ++q) { vr4[q] = *(const LAS f32x4*)(VLs + n * 20 + 4 * q); vi4[q] = *(const LAS f32x4*)(VLs + (64 + n) * 20 + 4 * q); }
        __builtin_amdgcn_sched_barrier(0);
#pragma unroll
        for (int s = 0; s < 16; ++s) {
            const float nxr = ar * xr - ai * xi + vr4[s >> 2][s & 3], nxi = ar * xi + ai * xr + vi4[s >> 2][s & 3];
            xr = nxr; xi = nxi;
            const unsigned pw = pkbf(xr, xi);
            XB[s * 136 + n] = (bf16_t)(pw & 0xffffu); XB[s * 136 + 64 + n] = (bf16_t)(pw >> 16);
        }
        asm volatile("" ::: "memory");
        if (!(l == 1 && ch < CTXL / 16)) {
        f32x4 acc = (f32x4){0.f, 0.f, 0.f, 0.f};
#pragma unroll
        for (int kk = 0; kk < 4; ++kk) { const bf16x8 a = *(const LAS bf16x8*)(XB + c * 136 + 32 * kk + quad * 8); acc = __builtin_amdgcn_mfma_f32_16x16x32_bf16(a, Cop[kk], acc, 0, 0, 0); }
#pragma unroll
        for (int j = 0; j < 4; ++j) { const int t = quad * 4 + j; const int rt = Rb[t]; const float yv = acc[j] + dsk * Ub[t * 16 + c];
            Y[(size_t)rt * DM + 512 + g * 16 + c] = (bf16_t)(pkbf(yv, 0.f) & 0xffffu); }
        }
        asm volatile("" ::: "memory");
      }
    }
#undef S5_LOAD
}

__device__ __forceinline__ void scan_phase(const KP P, int l, LAS unsigned char* lds, int wid, int lane, int bid) {
    const int v = (bid & 7) * 32 + (bid >> 3), b = v >> 3, dir = (v >> 2) & 1;
    if (wid < 4) {
        const int h = ((v >> 1) & 1) * 4 + (v & 1) * 2 + (wid >> 1), half = wid & 1;
        ssd_mfma_unit(P, l, ((b * 2 + dir) * 8 + h) * 2 + half, lds + wid * 22528, lane);
        if (wid >= 2) { int lane2 = lane; asm volatile("" : "+v"(lane2)); hg_mfma_unit(P, l, ((b * 2 + dir) * 4 + (v & 3)) * 2 + (wid - 2), lds + wid * 22528, lane2); }
    } else {
        LAS unsigned char* wlb = lds + 90112 + (wid - 4) * 16896;
        s5_unit(P, l, b, dir, (v & 3) * 4 + (wid - 4), (LAS float*)wlb, lane);
    }
}

struct CombIn { u32x4 ya, yb, z; u32x2 fa, fb, ha, hb, gg; };
__device__ __forceinline__ CombIn comb_load(const bf16_t* p, const bf16_t* Yf, const bf16_t* Yb, int row, int lane) {
    CombIn r; const int c8 = lane * 8, c4 = lane * 4;
    r.ya = *(const u32x4*)(Yf + (size_t)row * DM + c8); r.yb = *(const u32x4*)(Yb + (size_t)row * DM + c8); r.z = *(const u32x4*)(p + (size_t)row * INC + c8);
    r.fa = *(const u32x2*)(Yf + (size_t)row * DM + 512 + c4); r.fb = *(const u32x2*)(Yb + (size_t)row * DM + 512 + c4);
    r.ha = *(const u32x2*)(Yf + (size_t)row * DM + 768 + c4); r.hb = *(const u32x2*)(Yb + (size_t)row * DM + 768 + c4);
    r.gg = *(const u32x2*)(p + (size_t)row * INC + PC_G + c4);
    return r;
}
__device__ __forceinline__ void comb_row(const CombIn& r, bf16_t* mix, bf16_t* ybuf, const float* anw, const float* hnw, int row, int lane) {
    {
        const int c = lane * 8;
        float a[8], bq[8], z[8];
        unpack8(r.ya, a); unpack8(r.yb, bq); unpack8(r.z, z);
        float ss = 0.f;
#pragma unroll
        for (int j = 0; j < 8; ++j) { a[j] = (a[j] + bq[j]) * siluf_(z[j]); ss += a[j] * a[j]; }
        const float rstd = rsqrtf(wave_sum(ss, lane) * (1.0f / 512.0f) + EPS);
        const f32x4 w0 = *(const f32x4*)(anw + c), w1 = *(const f32x4*)(anw + c + 4);
        u32x4 w; w.x = pkbf(a[0] * rstd * w0.x, a[1] * rstd * w0.y); w.y = pkbf(a[2] * rstd * w0.z, a[3] * rstd * w0.w);
        w.z = pkbf(a[4] * rstd * w1.x, a[5] * rstd * w1.y); w.w = pkbf(a[6] * rstd * w1.z, a[7] * rstd * w1.w);
        *(u32x4*)(mix + (size_t)row * DM + c) = w;
    }
    {
        const int c = lane * 4;
        float y[4] = {bf_lo(r.fa.x) + bf_lo(r.fb.x), bf_hi(r.fa.x) + bf_hi(r.fb.x), bf_lo(r.fa.y) + bf_lo(r.fb.y), bf_hi(r.fa.y) + bf_hi(r.fb.y)};
#pragma unroll
        for (int j = 0; j < 4; ++j) { const float x = y[j]; y[j] = x * sigmoidf_(1.5957691216f * (x + 0.044715f * x * x * x)); }
        u32x2 w; w.x = pkbf(y[0], y[1]); w.y = pkbf(y[2], y[3]);
        *(u32x2*)(ybuf + (size_t)row * 256 + c) = w;
        float o[4] = {bf_lo(r.ha.x) + bf_lo(r.hb.x), bf_hi(r.ha.x) + bf_hi(r.hb.x), bf_lo(r.ha.y) + bf_lo(r.hb.y), bf_hi(r.ha.y) + bf_hi(r.hb.y)};
        float ss = (o[0] * o[0] + o[1] * o[1]) + (o[2] * o[2] + o[3] * o[3]);
        ss = row16_sum(ss);
        const float rstd = rsqrtf(ss * (1.0f / 64.0f) + EPS);
        const f32x4 nw4 = *(const f32x4*)(hnw + c);
        const float g0 = siluf_(bf_lo(r.gg.x)), g1 = siluf_(bf_hi(r.gg.x)), g2 = siluf_(bf_lo(r.gg.y)), g3 = siluf_(bf_hi(r.gg.y));
        u32x2 w2; w2.x = pkbf(o[0] * rstd * nw4.x * g0, o[1] * rstd * nw4.y * g1); w2.y = pkbf(o[2] * rstd * nw4.z * g2, o[3] * rstd * nw4.w * g3);
        *(u32x2*)(mix + (size_t)row * DM + 768 + c) = w2;
    }
}
__device__ __forceinline__ void combine_phase(const KP P, int l, int nrows, int gw, int nw, int lane) {
    const bf16_t* p = (const bf16_t*)(P.ws() + WS_P); const bf16_t* Yf = (const bf16_t*)(P.ws() + WS_YF); const bf16_t* Yb = (const bf16_t*)(P.ws() + WS_YB);
    bf16_t* mix = (bf16_t*)(P.ws() + WS_U); bf16_t* ybuf = (bf16_t*)(P.ws() + WS_YBUF);
    const float* anw = P.in(I_ANORM) + l * 512; const float* hnw = P.in(I_HGNORM) + l * 256;
    for (int row = gw; row < nrows; row += 3 * nw) {
        const int r1 = row + nw, r2 = row + 2 * nw; const bool h1 = r1 < nrows, h2 = r2 < nrows;
        const CombIn a = comb_load(p, Yf, Yb, row, lane), b = comb_load(p, Yf, Yb, h1 ? r1 : row, lane), c = comb_load(p, Yf, Yb, h2 ? r2 : row, lane);
        __builtin_amdgcn_sched_barrier(0);
        comb_row(a, mix, ybuf, anw, hnw, row, lane);
        if (h1) comb_row(b, mix, ybuf, anw, hnw, r1, lane);
        if (h2) comb_row(c, mix, ybuf, anw, hnw, r2, lane);
    }
}
#ifndef RESID_ALIGN
#define RESID_ALIGN true
#endif
constexpr int N_PHASES = 24;
__global__ void __launch_bounds__(NTHREADS, 2) fwd_kernel(Params Pk) {
    extern __shared__ __attribute__((aligned(16))) unsigned char smem[];
    LAS unsigned char* lds = (LAS unsigned char*)smem;
    cg::grid_group grid = cg::this_grid();
    const int G = gridDim.x, nw = G * 8;
    const int wid0 = __builtin_amdgcn_readfirstlane((int)threadIdx.x >> 6);
    kaptr_t ka = (kaptr_t)__builtin_amdgcn_kernarg_segment_ptr();
    const int ph_lo = KP{ka}.ph_lo(), ph_hi = KP{ka}.ph_hi();
    volatile LAS unsigned* xst = (volatile LAS unsigned*)(lds + LDS_BYTES - 16);
    { const int t0 = wid0 * 64 + (int)__builtin_amdgcn_mbcnt_hi(~0u, __builtin_amdgcn_mbcnt_lo(~0u, 0u)); if (t0 < 4) xst[t0] = 0u; __syncthreads(); }
    const XcdBarrier xbar = xcd_barrier_post((unsigned*)KP{ka}.ws(), xst, wid0 * 64 + (int)__builtin_amdgcn_mbcnt_hi(~0u, __builtin_amdgcn_mbcnt_lo(~0u, 0u)));
#ifdef PROBE_Q
    for (int pp = ph_lo; pp < ph_hi + 2; ++pp) {
        const int ph = pp <= 3 + PROBE_Q ? pp : (pp <= 14 + PROBE_Q ? pp - 1 : pp - 2);
        if (pp > ph_lo) grid.sync();
#else
    for (int ph = ph_lo; ph < ph_hi; ++ph) {
        unsigned zero_ = 0u; asm volatile("" : "+v"(zero_));
        int tid = wid0 * 64 + (int)__builtin_amdgcn_mbcnt_hi(~0u, __builtin_amdgcn_mbcnt_lo(~0u, zero_)); asm volatile("" : "+v"(tid));
        if (ph == ph_lo + 1) grid.sync();
        else if (ph > ph_lo) xcd_barrier(xbar, tid);
#ifdef PROBE_SYNC
        if (ph > ph_lo) { grid.sync(); grid.sync(); }
#endif
#endif
        asm volatile("" : "+s"(ka));
        const KP P{ka};
        unsigned char* ws = P.ws();
        float* hctx = (float*)(ws + WS_HCTX); bf16_t* ub = (bf16_t*)(ws + WS_U); bf16_t* pb = (bf16_t*)(ws + WS_P);
        float* SS = (float*)(ws + WS_SS);
        int bid = blockIdx.x; asm volatile("" : "+s"(bid));
        const int lane = tid & 63, wid = __builtin_amdgcn_readfirstlane(tid >> 6), gw = bid * 8 + wid;
        if (ph == 0) { prologue_phase(P, lds, tid, wid, lane, bid); continue; }
        if (ph == 1) { modreduce_phase(P, bid * NTHREADS + tid, G * NTHREADS); continue; }
        if (ph == 2) { prep_phase(P, lds, tid, gw, nw, lane); continue; }
        if (ph == N_PHASES - 1) { final_phase(P.out(), P.in(I_FNORM), gw, nw, lane); continue; }
        const int l = (ph - 3) / 10, q = (ph - 3) - l * 10;
        const float* modl = (const float*)(ws + WS_MOD) + (size_t)l * 33 * MODW;
        unsigned char* wlp = ws + WS_W + (size_t)l * W_LAYER;
        const float* biasl = (const float*)(ws + WS_BIAS) + (size_t)l * 3 * BIAS_TAB;
        const int nrows_late = l == 1 ? MLAT : MALL;
        const bool first = (l == 0 && q <= 1);
        const float* srcLat = first ? P.in(I_X) : P.out(); const float* srcCtx = first ? P.in(I_CTX) : hctx;
        if (q == 0 || q == 8) {
            const int j = q == 8 ? 1 : 0, M = j ? nrows_late : MALL;
            pg8::Gemm g{j ? (const bf16_t*)(ws + WS_YF) : ub, (const bf16_t*)(wlp + WO_FI + (size_t)j * FI_BYTES), M, 2 * DFF, DM}; pg8::StaticOrder S; S.init(M, 2 * DFF, G, bid);
            rstd_prestep(S, SS, lds, tid);
            pg8::EpiSwiglu E{pb, lds + 131072, biasl + (size_t)(j ? 2 : 0) * BIAS_TAB};
            pg8::gemm_phase<pg8::EpiSwiglu, pg8::StaticOrder, true, true>(lds, g, S, E, tid);
        } else if (q == 1 || q == 7 || q == 9) {
            const int M = q == 1 ? MALL : nrows_late;
            const bf16_t* A = q == 7 ? ub : pb;
            const bf16_t* Bt = (const bf16_t*)(q == 7 ? wlp + WO_WOUT : wlp + WO_FO + (size_t)(q == 9 ? 1 : 0) * FO_BYTES);
            const int K = q == 7 ? DM : DFF;
            pg8::Gemm g{A, Bt, M, DM, K}; pg8::StaticOrder S; S.init(M, DM, G, bid); S.rev = 1;
            pg8::EpiResid E{ka, l, q};
            pg8::gemm_phase<pg8::EpiResid, pg8::StaticOrder, RESID_ALIGN, true>(lds, g, S, E, tid);
        } else if (q == 2) {
            pg8::Gemm g{ub, (const bf16_t*)(wlp + WO_WIN), MALL, INCP, DM}; pg8::StaticOrder S; S.init(MALL, INCP, G, bid);
            rstd_prestep(S, SS, lds, tid);
            pg8::EpiP E{pb, INC, INC, lds + 131072, biasl + (size_t)1 * BIAS_TAB};
            pg8::gemm_phase<pg8::EpiP, pg8::StaticOrder, true, true>(lds, g, S, E, tid);
        } else if (q == 3) {
            conv_phase(pb, ub, P.in(I_CONVW) + l * 5 * 768, P.in(I_CONVB) + l * 768, l == 1, bid * NTHREADS + tid, G * NTHREADS);
            hg_prepass(P, l, gw, nw, lane);
        } else if (q == 4) {
            scan_phase(P, l, lds, wid, lane, bid);
        } else if (q == 5) {
            combine_phase(P, l, nrows_late, gw, nw, lane);
        } else if (q == 6) {
            const bf16_t* yb = (const bf16_t*)(ws + WS_YBUF);
            int kglu = 256; asm volatile("" : "+s"(kglu));
            pg8::Gemm g{yb, (const bf16_t*)(wlp + WO_GLU), nrows_late, 256, kglu}; pg8::StaticOrder S; S.init(nrows_late, 256, G, bid);
            pg8::EpiGlu E{yb, ub, P.in(I_GLUB) + l * 256};
            pg8::gemm_phase<pg8::EpiGlu, pg8::StaticOrder, true, true>(lds, g, S, E, tid);
        }
    }
}

extern "C" void kernel_launch(void* const* d_in, const int* in_sizes, int n_in, void* d_out, int out_size, void* d_ws, size_t ws_size, hipStream_t stream) {
    static int grid = 0;
    if (grid == 0) {
        if (n_in != 29 || out_size != MLAT * DM || ws_size < WS_END) { fprintf(stderr, "kernel_launch: unexpected shapes (n_in %d out %d ws %zu)\n", n_in, out_size, ws_size); grid = -1; return; }
        int dev = 0, cus = 0, per_cu = 0;
        (void)hipGetDevice(&dev); (void)hipDeviceGetAttribute(&cus, hipDeviceAttributeMultiprocessorCount, dev);
        if (hipFuncSetAttribute((const void*)fwd_kernel, hipFuncAttributeMaxDynamicSharedMemorySize, LDS_BYTES) != hipSuccess) { fprintf(stderr, "kernel_launch: hipFuncSetAttribute failed\n"); grid = -1; return; }
        if (hipOccupancyMaxActiveBlocksPerMultiprocessor(&per_cu, (const void*)fwd_kernel, NTHREADS, LDS_BYTES) != hipSuccess || per_cu < 1) { fprintf(stderr, "kernel_launch: occupancy query says %d\n", per_cu); per_cu = 1; }
        (void)hipGetLastError();
        grid = cus * per_cu;
        if (grid < 256) { fprintf(stderr, "kernel_launch: needs 256 co-resident workgroups, have %d\n", grid); grid = -1; return; }
        grid = 256;
        fprintf(stderr, "kernel_launch: grid %d (cus %d x %d)\n", grid, cus, per_cu);
    }
    if (grid < 0) return;
    if (hipMemsetAsync(d_ws, 0, 16384, stream) != hipSuccess) { fprintf(stderr, "kernel_launch: memset of the barrier words failed\n"); return; }
    Params p{};
    for (int i = 0; i < 29; ++i) p.in[i] = (const float*)d_in[i];
    p.out = (float*)d_out; p.ws = (unsigned char*)d_ws;
#ifdef MULTI_LAUNCH
    for (int ph = 0; ph < N_PHASES; ++ph) { p.ph_lo = ph; p.ph_hi = ph + 1; hipLaunchKernelGGL(fwd_kernel, dim3(grid), dim3(NTHREADS), LDS_BYTES, stream, p); }
#else
    p.ph_lo = 0; p.ph_hi = N_PHASES;
    void* args[] = {&p};
    hipError_t e = hipLaunchCooperativeKernel((const void*)fwd_kernel, dim3(grid), dim3(NTHREADS), args, LDS_BYTES, stream);
    if (e != hipSuccess) fprintf(stderr, "kernel_launch: cooperative launch failed: %s (grid %d)\n", hipGetErrorString(e), grid);
#endif
}
```

```cpp
#define HG_ON_SSD 1
#define PG8_WGM 4
#include <hip/hip_runtime.h>
#include <hip/hip_cooperative_groups.h>
#include <cstdio>
#include <cstdint>
namespace cg = cooperative_groups;
#ifndef PG8_WGM
#define PG8_WGM 8
#endif
namespace pg8 {
#define PG8_LAS __attribute__((address_space(3)))
typedef unsigned short bf16_t;
typedef short bf16x8 __attribute__((ext_vector_type(8)));
typedef float f32x4 __attribute__((ext_vector_type(4)));
typedef unsigned u32x4 __attribute__((ext_vector_type(4)));
constexpr int BM = 256, BK = 64, HALF = 128, HTB = HALF * BK * 2  , STAGE_BYTES = 8 * HTB, NXCD = 8, WGM = PG8_WGM;

__host__ __device__ __forceinline__ int lds_byte(int r, int c) { const int st = (r >> 4) * 2 + (c >> 5), rr = r & 15, cc = c & 31, ob = rr * 64 + cc * 2; return st * 1024 + (ob ^ (((ob >> 9) & 1) << 5)); }
__host__ __device__ __forceinline__ void stage_rc(int b, int& R, int& C) { const int st = b / 1024, sb = b % 1024, swz = sb ^ (((sb >> 9) & 1) << 5); R = (st >> 1) * 16 + swz / 64; C = (st & 1) * 32 + (swz % 64) / 2; }
__host__ __device__ __forceinline__ int perm32(int rho) { const int n = rho >> 4, i = rho & 15; return 8 * (i >> 2) + 4 * n + (i & 3); }

struct Unit { int pm, pn; };
struct Gemm { const bf16_t* A; const bf16_t* Bt; int M, N, K; };

struct StaticOrder {
    int nM, nN, nwg, G, c, rev;
    __host__ __device__ void init(int M, int N, int G_, int c_) { nM = M / BM; nN = N / BM; nwg = nM * nN; G = G_; c = c_; rev = 0; }
    __host__ __device__ bool next(int i, Unit& u) const {
        const long L = (long)i * G + c; if (L >= nwg) return false;
        int wgid = (int)L; { const int q = nwg / NXCD, r = nwg % NXCD, xcd = wgid % NXCD, off = wgid / NXCD; wgid = (xcd < r ? xcd * (q + 1) : r * (q + 1) + (xcd - r) * q) + off; }
        const int nig = WGM * nN, gid = wgid / nig, fm = gid * WGM, gsz = (nM - fm) < WGM ? (nM - fm) : WGM;
        u.pm = fm + ((wgid % nig) % gsz); u.pn = (wgid % nig) / gsz; if (rev) u.pm = nM - 1 - u.pm; return true;
    }
    __device__ __forceinline__ void a_ready(const Unit&) const {}
    __device__ __forceinline__ void done(const Unit&) const {}
};
__device__ __forceinline__ unsigned cvt_pk_bf16(float lo, float hi) { unsigned r; asm volatile("v_cvt_pk_bf16_f32 %0, %1, %2" : "=v"(r) : "v"(lo), "v"(hi)); return r; }

template <class Epi, class Sched, bool ALIGN_EPI = false, bool SP2 = false>
__device__ __forceinline__ void gemm_phase(PG8_LAS unsigned char* lds, const Gemm g, const Sched& S, const Epi& E, const int tid) {
    const int wid = __builtin_amdgcn_readfirstlane(tid >> 6), lane = tid & 63, wr = wid >> 2, wc = wid & 3, fr = lane & 15, fq = lane >> 4;
    const int K = g.K, nt = K / BK;
    unsigned voffA[2], voffB[2];
#pragma unroll
    for (int i = 0; i < 2; ++i) { int R, C; stage_rc(tid * 16 + i * 8192, R, C); const int Rb = Epi::PERM ? ((R & ~31) + perm32(R & 31)) : R;
        voffA[i] = (unsigned)(R * K + C) * 2u; voffB[i] = (unsigned)(Rb * K + C) * 2u; }
    const size_t kstep = (size_t)(BK * 2);
    const size_t hstep = (size_t)HALF * K * 2;
    const size_t tstep = 2 * hstep;
    const unsigned ldsw = (unsigned)wid * 1024u;
    const int aoff = lds_byte(wr * 64 + fr, fq * 8), boff = lds_byte(wc * 32 + fr, fq * 8);
#define PG8_SA(b, h) (((b) * 2 + (h)) * HTB)
#define PG8_SB(b, h) ((4 + (b) * 2 + (h)) * HTB)
#define PG8_STAGE(bufoff, gbase, voff) do { _Pragma("unroll") for (int _i = 0; _i < 2; ++_i) \
        __builtin_amdgcn_global_load_lds((const unsigned*)((const char*)(gbase) + (voff)[_i]), (PG8_LAS unsigned*)(lds + (bufoff) + ldsw + _i * 8192), 16, 0, 0); } while (0)
#define PG8_LDA(dst, b, h) do { _Pragma("unroll") for (int m = 0; m < 4; ++m) _Pragma("unroll") for (int k = 0; k < 2; ++k) dst[m][k] = *(const PG8_LAS bf16x8*)(lds + PG8_SA(b, h) + aoff + m * 2048 + k * 1024); } while (0)
#define PG8_LDB(dst, b, h) do { _Pragma("unroll") for (int n = 0; n < 2; ++n) _Pragma("unroll") for (int k = 0; k < 2; ++k) dst[n][k] = *(const PG8_LAS bf16x8*)(lds + PG8_SB(b, h) + boff + n * 2048 + k * 1024); } while (0)
#define PG8_MMA(ai, bj, At, Bt) do { __builtin_amdgcn_s_setprio(1); _Pragma("unroll") for (int m = 0; m < 4; ++m) _Pragma("unroll") for (int n = 0; n < 2; ++n) _Pragma("unroll") for (int k = 0; k < 2; ++k) \
        acc[ai][bj][m][n] = __builtin_amdgcn_mfma_f32_16x16x32_bf16(Bt[n][k], At[m][k], acc[ai][bj][m][n], 0, 0, 0); __builtin_amdgcn_s_setprio(0); } while (0)
#define PG8_WAIT_V(n) asm volatile("s_waitcnt vmcnt(" #n ")" ::: "memory")
#define PG8_WAIT_L(n) asm volatile("s_waitcnt lgkmcnt(" #n ")" ::: "memory")
#define PG8_BAR __builtin_amdgcn_s_barrier()
#define PG8_SCHED __builtin_amdgcn_sched_barrier(0)
    Unit cur, nxt; int ui = 0;
    if (!S.next(0, cur)) return;
    f32x4 acc[2][2][4][2];
#pragma unroll
    for (int a = 0; a < 2; ++a)
#pragma unroll
        for (int b = 0; b < 2; ++b)
#pragma unroll
            for (int m = 0; m < 4; ++m)
#pragma unroll
                for (int n = 0; n < 2; ++n) acc[a][b][m][n] = (f32x4){0.f, 0.f, 0.f, 0.f};
    bf16x8 At[4][2], B0[2][2], B1[2][2];
    const char* cA = (const char*)g.A + (size_t)cur.pm * tstep; const char* cB = (const char*)g.Bt + (size_t)cur.pn * tstep;
    S.a_ready(cur);
    if constexpr (SP2) {
        PG8_STAGE(PG8_SB(0, 0), cB, voffB); PG8_STAGE(PG8_SB(0, 1), cB + hstep, voffB); PG8_STAGE(PG8_SA(0, 0), cA, voffA); PG8_STAGE(PG8_SA(0, 1), cA + hstep, voffA);
        if (wr == 1) PG8_BAR;
        PG8_WAIT_V(2); PG8_BAR;
        PG8_STAGE(PG8_SB(1, 0), cB + kstep, voffB); PG8_STAGE(PG8_SA(1, 0), cA + kstep, voffA); PG8_STAGE(PG8_SB(1, 1), cB + hstep + kstep, voffB);
        PG8_WAIT_V(6); PG8_BAR;
    } else {
        PG8_STAGE(PG8_SB(0, 0), cB, voffB); PG8_STAGE(PG8_SA(0, 0), cA, voffA); PG8_STAGE(PG8_SB(0, 1), cB + hstep, voffB); PG8_STAGE(PG8_SA(0, 1), cA + hstep, voffA);
        if (wr == 1) PG8_BAR;
        PG8_WAIT_V(4); PG8_BAR;
        PG8_STAGE(PG8_SB(1, 0), cB + kstep, voffB); PG8_STAGE(PG8_SA(1, 0), cA + kstep, voffA); PG8_STAGE(PG8_SB(1, 1), cB + hstep + kstep, voffB);
        PG8_WAIT_V(6); PG8_BAR;
    }
    for (;;) {
        const bool has_next = S.next(ui + 1, nxt);
        const char* nA = has_next ? (const char*)g.A + (size_t)nxt.pm * tstep : cA; const char* nB = has_next ? (const char*)g.Bt + (size_t)nxt.pn * tstep : cB;
        for (int t = 0; t < nt; t += 2) {
            const bool last = (t == nt - 2);
            const char* a1 = cA + (size_t)(t + 1) * kstep;
            const char* a2 = last ? nA : cA + (size_t)(t + 2) * kstep; const char* b2 = last ? nB : cB + (size_t)(t + 2) * kstep;
            const char* a3 = a2 + kstep; const char* b3 = b2 + kstep;
            if (last && has_next) S.a_ready(nxt);
            if constexpr (SP2) {
            PG8_LDB(B0, 0, 0); PG8_LDB(B1, 0, 1); PG8_SCHED; PG8_LDA(At, 0, 0); PG8_STAGE(PG8_SA(1, 1), a1 + hstep, voffA);
            PG8_WAIT_V(8); PG8_WAIT_L(0); PG8_BAR; PG8_MMA(0, 0, At, B0); PG8_MMA(0, 1, At, B1); PG8_BAR; PG8_SCHED;
            PG8_LDA(At, 0, 1); PG8_STAGE(PG8_SB(0, 0), b2, voffB); PG8_STAGE(PG8_SB(0, 1), b2 + hstep, voffB); PG8_STAGE(PG8_SA(0, 0), a2, voffA);
            PG8_WAIT_V(8); PG8_WAIT_L(0); PG8_BAR; PG8_MMA(1, 0, At, B0); PG8_MMA(1, 1, At, B1); PG8_BAR; PG8_SCHED;
            PG8_LDB(B0, 1, 0); PG8_LDB(B1, 1, 1); PG8_SCHED; PG8_LDA(At, 1, 0); PG8_STAGE(PG8_SA(0, 1), a2 + hstep, voffA);
            PG8_WAIT_V(8); PG8_WAIT_L(0); PG8_BAR; PG8_MMA(0, 0, At, B0); PG8_MMA(0, 1, At, B1); PG8_BAR; PG8_SCHED;
            PG8_LDA(At, 1, 1); PG8_STAGE(PG8_SB(1, 0), b3, voffB); PG8_STAGE(PG8_SB(1, 1), b3 + hstep, voffB); PG8_STAGE(PG8_SA(1, 0), a3, voffA);
            PG8_WAIT_V(8); PG8_WAIT_L(0); PG8_BAR; PG8_MMA(1, 0, At, B0); PG8_MMA(1, 1, At, B1); PG8_BAR; PG8_SCHED;
            } else {
            PG8_LDB(B0, 0, 0); PG8_SCHED; PG8_LDA(At, 0, 0); PG8_STAGE(PG8_SA(1, 1), a1 + hstep, voffA);
            PG8_WAIT_L(8); PG8_BAR; PG8_WAIT_L(0); PG8_MMA(0, 0, At, B0); PG8_BAR; PG8_SCHED;
            PG8_LDB(B1, 0, 1); PG8_STAGE(PG8_SB(0, 0), b2, voffB);
            PG8_BAR; PG8_WAIT_L(0); PG8_MMA(0, 1, At, B1); PG8_BAR;
            PG8_LDA(At, 0, 1); PG8_STAGE(PG8_SA(0, 0), a2, voffA);
            PG8_BAR; PG8_WAIT_L(0); PG8_MMA(1, 0, At, B0); PG8_BAR; PG8_SCHED;
            PG8_STAGE(PG8_SB(0, 1), b2 + hstep, voffB);
            PG8_WAIT_V(6); PG8_BAR; PG8_MMA(1, 1, At, B1); PG8_BAR;
            PG8_LDB(B0, 1, 0); PG8_SCHED; PG8_LDA(At, 1, 0); PG8_STAGE(PG8_SA(0, 1), a2 + hstep, voffA);
            PG8_WAIT_L(8); PG8_BAR; PG8_WAIT_L(0); PG8_MMA(0, 0, At, B0); PG8_BAR; PG8_SCHED;
            PG8_LDB(B1, 1, 1); PG8_STAGE(PG8_SB(1, 0), b3, voffB);
            PG8_BAR; PG8_WAIT_L(0); PG8_MMA(0, 1, At, B1); PG8_BAR;
            PG8_LDA(At, 1, 1); PG8_STAGE(PG8_SA(1, 0), a3, voffA);
            PG8_BAR; PG8_WAIT_L(0); PG8_MMA(1, 0, At, B0); PG8_BAR; PG8_SCHED;
            PG8_STAGE(PG8_SB(1, 1), b3 + hstep, voffB);
            PG8_WAIT_V(6); PG8_BAR; PG8_MMA(1, 1, At, B1); PG8_BAR;
            }
        }
        if constexpr (ALIGN_EPI) { if (wr == 0) PG8_BAR; }
        if constexpr (!Epi::AFTER_DRAIN) { E(acc, cur, wr, wc, fr, fq, ui); S.done(cur); }
        if (!has_next) break;
#pragma unroll
        for (int a = 0; a < 2; ++a)
#pragma unroll
            for (int b = 0; b < 2; ++b)
#pragma unroll
                for (int m = 0; m < 4; ++m)
#pragma unroll
                    for (int n = 0; n < 2; ++n) acc[a][b][m][n] = (f32x4){0.f, 0.f, 0.f, 0.f};
        cur = nxt; cA = nA; cB = nB; ++ui;
        if constexpr (ALIGN_EPI) { if (wr == 1) PG8_BAR; }
    }
    PG8_WAIT_V(0);
    if constexpr (!ALIGN_EPI) { if (wr == 0) PG8_BAR; }
    PG8_BAR;
    if constexpr (Epi::AFTER_DRAIN) { E.fused(acc, cur, wr, wc, fr, fq, lds, wid, lane); S.done(cur); }
#undef PG8_SA
#undef PG8_SB
#undef PG8_STAGE
#undef PG8_LDA
#undef PG8_LDB
#undef PG8_MMA
#undef PG8_WAIT_V
#undef PG8_WAIT_L
#undef PG8_BAR
#undef PG8_SCHED
}
}
#define LAS __attribute__((address_space(3)))
typedef unsigned short bf16_t;
typedef float f32x4 __attribute__((ext_vector_type(4)));
typedef float f32x2 __attribute__((ext_vector_type(2)));
typedef unsigned u32x4 __attribute__((ext_vector_type(4)));
typedef unsigned u32x2 __attribute__((ext_vector_type(2)));
typedef short bf16x8 __attribute__((ext_vector_type(8)));

constexpr int DM = 1024, NBATCH = 32, SEQ = 2048, CTXL = 256, DFF = 2816, INC = 2832, INCP = 3072;
constexpr int MLAT = NBATCH * SEQ, MCTX = NBATCH * CTXL, MALL = MLAT + MCTX;
constexpr int MODW = 9 * DM;
constexpr float EPS = 1e-6f;
constexpr int PC_XBC = 512, PC_DT = 1280, PC_S5 = 1296, PC_Q = 1552, PC_F = 1808, PC_I = 2320, PC_G = 2576;
constexpr int NSTEP = CTXL + SEQ;

constexpr size_t MiB = 1u << 20;
constexpr size_t WS_MOD = 1 * MiB;
constexpr size_t WS_LB = 3 * MiB + 512 * 1024;
constexpr size_t WS_MODP = 987 * MiB;
constexpr size_t WS_W = 4 * MiB, W_LAYER = 42 * MiB;
constexpr size_t WO_FI = 0, WO_FO = 22 * MiB, WO_WIN = 33 * MiB, WO_WOUT = 39 * MiB, WO_GLU = 41 * MiB;
constexpr size_t FI_BYTES = 11 * MiB, FO_BYTES = 5767168;
constexpr size_t WS_HCTX = 88 * MiB, WS_U = 120 * MiB, WS_P = 264 * MiB, WS_YF = 663 * MiB, WS_YB = 807 * MiB, WS_YBUF = 951 * MiB, WS_SS = 1007 * MiB, WS_BIAS = 1012 * MiB, WS_END = 1017 * MiB;
constexpr int LDS_BYTES = 163840;
constexpr int BIAS_LD = 5632, BIAS_TAB = 33 * BIAS_LD;
constexpr int NTHREADS = 512;

struct Params { const float* in[29]; float* out; unsigned char* ws; int ph_lo, ph_hi; };
typedef __attribute__((address_space(4))) const unsigned long long* kaptr_t;
struct KP { kaptr_t ka;
    __device__ __forceinline__ const float* in(int i) const { return (const float*)(const __attribute__((address_space(1))) float*)ka[i]; }
    __device__ __forceinline__ float* out() const { return (float*)(__attribute__((address_space(1))) float*)ka[29]; }
    __device__ __forceinline__ unsigned char* ws() const { return (unsigned char*)(__attribute__((address_space(1))) unsigned char*)ka[30]; }
    __device__ __forceinline__ int ph_lo() const { return ((__attribute__((address_space(4))) const int*)ka)[62]; }
    __device__ __forceinline__ int ph_hi() const { return ((__attribute__((address_space(4))) const int*)ka)[63]; }
};
static_assert(sizeof(Params) == 256, "Params layout");

enum { I_X = 0, I_C, I_CTX, I_CCTX, I_MODW, I_MODB, I_FFNIN, I_FFNOUT, I_WIN, I_WOUT, I_CONVW, I_CONVB, I_DTB, I_ALOG, I_AD, I_ANORM,
       I_LRE, I_LIM, I_LSTEP, I_BRE, I_BIM, I_CRE, I_CIM, I_S5D, I_GLUW, I_GLUB, I_HGLB, I_HGNORM, I_FNORM };

__device__ __forceinline__ float bf_lo(unsigned w) { return __builtin_bit_cast(float, w << 16); }
__device__ __forceinline__ float bf_hi(unsigned w) { return __builtin_bit_cast(float, w & 0xffff0000u); }
__device__ __forceinline__ float bf1(bf16_t h) { return __builtin_bit_cast(float, (unsigned)h << 16); }
typedef __bf16 bf16x2_t __attribute__((ext_vector_type(2)));
__device__ __forceinline__ unsigned pkbf(float lo, float hi) { const f32x2 v = {lo, hi}; const bf16x2_t b = __builtin_convertvector(v, bf16x2_t); return __builtin_bit_cast(unsigned, b); }
__device__ __forceinline__ float frcp(float x) { return __builtin_amdgcn_rcpf(x); }
__device__ __forceinline__ float sigmoidf_(float x) { return frcp(1.0f + __expf(-x)); }
__device__ __forceinline__ float siluf_(float x) { return x * sigmoidf_(x); }
template <int CTRL> __device__ __forceinline__ float dpp_f(float v) {
    return __builtin_bit_cast(float, __builtin_amdgcn_update_dpp(0, __builtin_bit_cast(int, v), CTRL, 0xf, 0xf, true));
}
__device__ __forceinline__ float row16_sum(float v) {
    v += dpp_f<0xB1>(v); v += dpp_f<0x4E>(v); v += dpp_f<0x141>(v); v += dpp_f<0x140>(v); return v;
}
__device__ __forceinline__ float wave_sum(float v, int lane) {
    v = row16_sum(v);
    v += __builtin_bit_cast(float, __builtin_amdgcn_ds_bpermute((lane ^ 16) << 2, __builtin_bit_cast(int, v)));
    v += __builtin_bit_cast(float, __builtin_amdgcn_ds_bpermute((lane ^ 32) << 2, __builtin_bit_cast(int, v)));
    return v;
}
__device__ __forceinline__ void unpack8(const u32x4 w, float* f) {
    f[0] = bf_lo(w.x); f[1] = bf_hi(w.x); f[2] = bf_lo(w.y); f[3] = bf_hi(w.y); f[4] = bf_lo(w.z); f[5] = bf_hi(w.z); f[6] = bf_lo(w.w); f[7] = bf_hi(w.w);
}

#define XB_TMO      128
#define XB_XCNT(j)  (256  + 64 * (j))
#define XB_XSUB(j)  (1280 + 64 * (j))
#define XB_XGEN(j)  (2304 + 64 * (j))
#define XB_TOP      3328
#define XB_TOPGEN   3392
#define XCD_BAR_WORDS 3456
#define XB_SPIN_CAP (1u << 18)

__device__ __forceinline__ unsigned xb_ld(unsigned* p)              { return __hip_atomic_load(p, __ATOMIC_RELAXED, __HIP_MEMORY_SCOPE_AGENT); }
__device__ __forceinline__ unsigned xb_add(unsigned* p, unsigned v) { return __hip_atomic_fetch_add(p, v, __ATOMIC_RELAXED, __HIP_MEMORY_SCOPE_AGENT); }
__device__ __forceinline__ unsigned xb_xcc_id() { return (unsigned)__builtin_amdgcn_s_getreg((3 << 11) | 20) & 0xFu; }
#define XB_SPIN(cond, bar) do { unsigned _sp = 0; while (cond) { __builtin_amdgcn_s_sleep(1); \
    if ((++_sp & 255u) == 0u) { if (xb_ld(&(bar)[XB_TMO])) break; if (_sp > XB_SPIN_CAP) { atomicAdd(&(bar)[XB_TMO], 1u); break; } } } } while (0)

struct XcdBarrier {
    unsigned* bar; unsigned x;
    volatile LAS unsigned* st;
};

__device__ __forceinline__ XcdBarrier xcd_barrier_post(unsigned* bar, volatile LAS unsigned* st, int tid) {
    XcdBarrier b; b.bar = bar; b.x = xb_xcc_id(); b.st = st;
    if (tid == 0) (void)xb_add(&bar[XB_XCNT(b.x)], 1u);
    return b;
}
__device__ __forceinline__ void xcd_barrier_complete(unsigned* bar, unsigned x, unsigned& nloc, unsigned& nx) {
    const unsigned G = gridDim.x * gridDim.y * gridDim.z;
    unsigned sum, cnt, mine, sp = 0u;
    for (;;) {
        sum = 0u; cnt = 0u; mine = 0u;
#pragma unroll
        for (unsigned j = 0; j < 16; ++j) { const unsigned c = xb_ld(&bar[XB_XCNT(j)]); sum += c; cnt += (c > 0u) ? 1u : 0u; mine = (j == x) ? c : mine; }
        if (sum == G) break;
        __builtin_amdgcn_s_sleep(1);
        if ((++sp & 255u) == 0u) { if (xb_ld(&bar[XB_TMO])) break; if (sp > XB_SPIN_CAP) { atomicAdd(&bar[XB_TMO], 1u); break; } }
    }
    nloc = mine > 0u ? mine : 1u; nx = cnt > 0u ? cnt : 1u;
}

__device__ __forceinline__ void xcd_barrier(const XcdBarrier& b, int tid) {
    asm volatile("s_waitcnt vmcnt(0)" ::: "memory");
    __syncthreads();
    if (tid == 0) {
        unsigned* bar = b.bar;
        __builtin_amdgcn_s_waitcnt(0);
        unsigned nloc = b.st[0], nx = b.st[1];
        if (nloc == 0u) { xcd_barrier_complete(bar, b.x, nloc, nx); b.st[0] = nloc; b.st[1] = nx; }
        const unsigned old = xb_add(&bar[XB_XSUB(b.x)], 1u);
        const unsigned gen = old / nloc;
        if (old + 1u == (gen + 1u) * nloc) {
            __builtin_amdgcn_fence(__ATOMIC_RELEASE, "agent");
            asm volatile("s_waitcnt vmcnt(0)" ::: "memory");
            const unsigned og = xb_add(&bar[XB_TOP], 1u);
            const unsigned tg = og / nx;
            if (og + 1u == (tg + 1u) * nx) xb_add(&bar[XB_TOPGEN], 1u);
            else XB_SPIN(xb_ld(&bar[XB_TOPGEN]) == tg, bar);
            __builtin_amdgcn_fence(__ATOMIC_ACQUIRE, "agent");
            xb_add(&bar[XB_XGEN(b.x)], 1u);
            asm volatile("s_waitcnt vmcnt(0)" ::: "memory");
        } else {
            XB_SPIN(xb_ld(&bar[XB_XGEN(b.x)]) == gen, bar);
            __builtin_amdgcn_fence(__ATOMIC_ACQUIRE, "agent");
            asm volatile("s_waitcnt vmcnt(0)" ::: "memory");
        }
    }
    __syncthreads();
}

namespace pg8 {
__device__ __forceinline__ float row_rstd(const float* SS, size_t row) {
    const f32x4 a = *(const f32x4*)(SS + row * 16), b = *(const f32x4*)(SS + row * 16 + 4), c = *(const f32x4*)(SS + row * 16 + 8), d = *(const f32x4*)(SS + row * 16 + 12);
    const f32x4 s = (a + b) + (c + d);
    return rsqrtf(((s.x + s.y) + (s.z + s.w)) * (1.0f / 1024.0f) + 1e-6f);
}
struct EpiSwiglu {
    static constexpr bool PERM = true, AFTER_DRAIN = false;
    bf16_t* O; PG8_LAS unsigned char* RS; const float* bias;
    __device__ __forceinline__ void operator()(const f32x4 (&acc)[2][2][4][2], const Unit& u, int wr, int wc, int fr, int fq, int ui) const {
        asm volatile("" : "+v"(fr), "+v"(fq));
        const int row0 = u.pm * BM + wr * 64 + fr, col0 = u.pn * 128 + wc * 32 + 8 * fq;
        const int mrow = u.pm < 256 ? (u.pm >> 3) : 32;
        const float* bg = bias + (size_t)mrow * 5632 + u.pn * BM + wc * 32 + 8 * fq;
        const f32x4 bg0 = *(const f32x4*)bg, bg1 = *(const f32x4*)(bg + 4), bu0 = *(const f32x4*)(bg + 128), bu1 = *(const f32x4*)(bg + 132);
#pragma unroll
        for (int ai = 0; ai < 2; ++ai)
#pragma unroll
            for (int m = 0; m < 4; ++m) {
                const size_t row = (size_t)(row0 + ai * HALF + m * 16);
                const float rs = ((const PG8_LAS float*)RS)[ui * 256 + wr * 64 + fr + ai * HALF + m * 16];
                bf16_t* rowp = O + row * 2816 + col0;
                float v[8];
#pragma unroll
                for (int n = 0; n < 2; ++n)
#pragma unroll
                    for (int j = 0; j < 4; ++j) { const float g = acc[ai][0][m][n][j] * rs + (n ? bg1[j] : bg0[j]), up = acc[ai][1][m][n][j] * rs + (n ? bu1[j] : bu0[j]); v[n * 4 + j] = g * __builtin_amdgcn_rcpf(1.0f + __expf(-g)) * up; }
                u32x4 w; w.x = cvt_pk_bf16(v[0], v[1]); w.y = cvt_pk_bf16(v[2], v[3]); w.z = cvt_pk_bf16(v[4], v[5]); w.w = cvt_pk_bf16(v[6], v[7]);
                *(u32x4*)rowp = w;
            }
    }
};
struct EpiP {
    static constexpr bool PERM = true, AFTER_DRAIN = false;
    bf16_t* O; int ldc; int nvalid; PG8_LAS unsigned char* RS; const float* bias;
    __device__ __forceinline__ void operator()(const f32x4 (&acc)[2][2][4][2], const Unit& u, int wr, int wc, int fr, int fq, int ui) const {
        asm volatile("" : "+v"(fr), "+v"(fq));
        const int row0 = u.pm * BM + wr * 64 + fr;
        const int mrow = u.pm < 256 ? (u.pm >> 3) : 32;
        float rs[2][4];
#pragma unroll
        for (int ai = 0; ai < 2; ++ai)
#pragma unroll
            for (int m = 0; m < 4; ++m) rs[ai][m] = ((const PG8_LAS float*)RS)[ui * 256 + wr * 64 + fr + ai * HALF + m * 16];
#pragma unroll
        for (int bj = 0; bj < 2; ++bj) {
            const int col = u.pn * BM + bj * HALF + wc * 32 + 8 * fq;
            if (col < nvalid) {
                const f32x4 b0 = *(const f32x4*)(bias + (size_t)mrow * 5632 + col), b1 = *(const f32x4*)(bias + (size_t)mrow * 5632 + col + 4);
#pragma unroll
                for (int ai = 0; ai < 2; ++ai)
#pragma unroll
                    for (int m = 0; m < 4; ++m) {
                        const f32x4 v0 = acc[ai][bj][m][0] * rs[ai][m] + b0, v1 = acc[ai][bj][m][1] * rs[ai][m] + b1;
                        u32x4 w; w.x = cvt_pk_bf16(v0[0], v0[1]); w.y = cvt_pk_bf16(v0[2], v0[3]); w.z = cvt_pk_bf16(v1[0], v1[1]); w.w = cvt_pk_bf16(v1[2], v1[3]);
                        *(u32x4*)(O + (size_t)(row0 + ai * HALF + m * 16) * ldc + col) = w;
                    }
            }
        }
    }
};
struct EpiResid {
    static constexpr bool PERM = true, AFTER_DRAIN = false;
    kaptr_t ka; int l, q;
    __device__ __forceinline__ void operator()(const f32x4 (&acc)[2][2][4][2], const Unit& u, int wr, int wc, int fr, int fq, int ui) const {
        asm volatile("" : "+v"(fr), "+v"(fq));
        kaptr_t k2 = ka; asm volatile("" : "+s"(k2));
        const KP P{k2};
        unsigned char* ws = P.ws();
        const bool first = (l == 0 && q == 1);
        float* hctx = (float*)(ws + WS_HCTX);
        const float* srcLat = first ? P.in(I_X) : P.out(); const float* srcCtx = first ? P.in(I_CTX) : hctx; float* dstLat = P.out(); float* dstCtx = hctx;
        const float* modl = (const float*)(ws + WS_MOD) + (size_t)l * 33 * MODW;
        const int midx = q == 1 ? 2 : (q == 7 ? 5 : 8); const float coef = q == 7 ? 1.0f : 0.5f;
        bf16_t* xs = (bf16_t*)(ws + (q == 7 ? WS_YF : WS_U)); float* SS = (float*)(ws + WS_SS);
        const float* nscale = q == 1 ? modl + 4 * DM : (q == 7 ? modl + 7 * DM : (l == 0 ? modl + (size_t)33 * MODW + 1 * DM : nullptr));
        const bool lat = u.pm < (MLAT / BM);
        const int mrow = lat ? (u.pm >> 3) : 32;
        const float* mv = modl + (size_t)mrow * MODW + midx * DM;
        const size_t rbase = (size_t)(lat ? u.pm : u.pm - MLAT / BM) * BM + wr * 64 + fr;
        const size_t grow = (size_t)u.pm * BM + wr * 64 + fr;
        const float* src = lat ? srcLat : srcCtx; float* dst = lat ? dstLat : dstCtx;
        float ss[2][4];
#pragma unroll
        for (int ai = 0; ai < 2; ++ai)
#pragma unroll
            for (int m = 0; m < 4; ++m) ss[ai][m] = 0.f;
#pragma unroll
        for (int bj = 0; bj < 2; ++bj) {
            const int c = u.pn * BM + bj * HALF + wc * 32 + 8 * fq;
            const f32x4 mm0 = *(const f32x4*)(mv + c) * coef, mm1 = *(const f32x4*)(mv + c + 4) * coef;
            f32x4 sc0 = (f32x4){1.f, 1.f, 1.f, 1.f}, sc1 = sc0;
            if (nscale) { sc0 = *(const f32x4*)(nscale + (size_t)mrow * MODW + c) + 1.0f; sc1 = *(const f32x4*)(nscale + (size_t)mrow * MODW + c + 4) + 1.0f; }
#pragma unroll
            for (int ai = 0; ai < 2; ++ai)
#pragma unroll
                for (int m = 0; m < 4; ++m) {
                    const size_t off = (rbase + ai * HALF + m * 16) * DM + c;
                    const f32x4 h0 = *(const f32x4*)(src + off) + mm0 * acc[ai][bj][m][0], h1 = *(const f32x4*)(src + off + 4) + mm1 * acc[ai][bj][m][1];
                    *(f32x4*)(dst + off) = h0; *(f32x4*)(dst + off + 4) = h1;
                    if (nscale) {
                        ss[ai][m] += ((h0.x * h0.x + h0.y * h0.y) + (h0.z * h0.z + h0.w * h0.w)) + ((h1.x * h1.x + h1.y * h1.y) + (h1.z * h1.z + h1.w * h1.w));
                        const f32x4 x0 = h0 * sc0, x1 = h1 * sc1;
                        u32x4 w; w.x = cvt_pk_bf16(x0.x, x0.y); w.y = cvt_pk_bf16(x0.z, x0.w); w.z = cvt_pk_bf16(x1.x, x1.y); w.w = cvt_pk_bf16(x1.z, x1.w);
                        *(u32x4*)(xs + (grow + ai * HALF + m * 16) * DM + c) = w;
                    }
                }
        }
        if (nscale) {
            const int lane = fr + 16 * fq;
#pragma unroll
            for (int ai = 0; ai < 2; ++ai)
#pragma unroll
                for (int m = 0; m < 4; ++m) {
                    float s = ss[ai][m];
                    s += __builtin_bit_cast(float, __builtin_amdgcn_ds_bpermute((lane ^ 16) << 2, __builtin_bit_cast(int, s)));
                    s += __builtin_bit_cast(float, __builtin_amdgcn_ds_bpermute((lane ^ 32) << 2, __builtin_bit_cast(int, s)));
                    if (fq == 0) SS[(grow + ai * HALF + m * 16) * 16 + u.pn * 4 + wc] = s;
                }
        }
    }
};
struct EpiGlu {
    static constexpr bool PERM = true, AFTER_DRAIN = false;
    const bf16_t* Y; bf16_t* mix; const float* gb;
    __device__ __forceinline__ void operator()(const f32x4 (&acc)[2][2][4][2], const Unit& u, int wr, int wc, int fr, int fq, int ui) const {
        asm volatile("" : "+v"(fr), "+v"(fq));
        const int row0 = u.pm * BM + wr * 64 + fr;
#pragma unroll
        for (int bj = 0; bj < 2; ++bj) {
            const int col = bj * HALF + wc * 32 + 8 * fq;
            const f32x4 b0 = *(const f32x4*)(gb + col), b1 = *(const f32x4*)(gb + col + 4);
#pragma unroll
            for (int ai = 0; ai < 2; ++ai)
#pragma unroll
                for (int m = 0; m < 4; ++m) {
                    const size_t row = (size_t)(row0 + ai * HALF + m * 16);
                    const u32x4 yw = *(const u32x4*)(Y + row * 256 + col);
                    const f32x4 v0 = acc[ai][bj][m][0] + b0, v1 = acc[ai][bj][m][1] + b1;
                    float y[8]; y[0] = __builtin_bit_cast(float, yw.x << 16); y[1] = __builtin_bit_cast(float, yw.x & 0xffff0000u); y[2] = __builtin_bit_cast(float, yw.y << 16); y[3] = __builtin_bit_cast(float, yw.y & 0xffff0000u);
                    y[4] = __builtin_bit_cast(float, yw.z << 16); y[5] = __builtin_bit_cast(float, yw.z & 0xffff0000u); y[6] = __builtin_bit_cast(float, yw.w << 16); y[7] = __builtin_bit_cast(float, yw.w & 0xffff0000u);
                    float o[8];
#pragma unroll
                    for (int j = 0; j < 4; ++j) { o[j] = y[j] * __builtin_amdgcn_rcpf(1.0f + __expf(-v0[j])); o[4 + j] = y[4 + j] * __builtin_amdgcn_rcpf(1.0f + __expf(-v1[j])); }
                    u32x4 w; w.x = cvt_pk_bf16(o[0], o[1]); w.y = cvt_pk_bf16(o[2], o[3]); w.z = cvt_pk_bf16(o[4], o[5]); w.w = cvt_pk_bf16(o[6], o[7]);
                    *(u32x4*)(mix + row * DM + 512 + col) = w;
                }
        }
    }
};
}
__device__ __forceinline__ void cvt_item(const float* src, int ldsrc, int scol0, int nvalid, bf16_t* dst, int lddst, LAS float* scr, int lane) {
    f32x4 v[8];
#pragma unroll
    for (int i = 0; i < 8; ++i) { const int kk = i * 8 + (lane >> 3), n4 = (lane & 7) * 4; v[i] = (n4 < nvalid) ? *(const f32x4*)(src + (size_t)kk * ldsrc + scol0 + n4) : (f32x4){0.f, 0.f, 0.f, 0.f}; }
#pragma unroll
    for (int i = 0; i < 8; ++i) { const int kk = i * 8 + (lane >> 3), n4 = (lane & 7) * 4; LAS float* s = scr + kk * 33 + n4; s[0] = v[i].x; s[1] = v[i].y; s[2] = v[i].z; s[3] = v[i].w; }
    const int c = lane & 7;
#pragma unroll
    for (int j = 0; j < 4; ++j) { const int n = (lane >> 3) + 8 * j; const LAS float* s = scr + (8 * c) * 33 + n;
        u32x4 o; o.x = pkbf(s[0], s[33]); o.y = pkbf(s[66], s[99]); o.z = pkbf(s[132], s[165]); o.w = pkbf(s[198], s[231]);
        *(u32x4*)(dst + (size_t)n * lddst + 8 * c) = o; }
}

__device__ __forceinline__ void prologue_phase(const KP P, LAS unsigned char* lds, int tid, int wid, int lane, int bid) {
    const int gw = bid * 8 + wid, nw = (int)gridDim.x * 8;
    {
    LAS float* scr = (LAS float*)(lds + 135168 + wid * 1024);
    (void)scr;
    }
    LAS float* scr = (LAS float*)(lds + wid * 16384);
    constexpr int PER_LAYER = 2 * 5264;
    for (int it = gw; it < 2 * PER_LAYER; it += nw) {
        const int l = it / PER_LAYER; int r = it - l * PER_LAYER;
        unsigned char* wl = P.ws() + WS_W + (size_t)l * W_LAYER;
        const float* src; int ldsrc, K, scol0, nvalid = 32, kt, nt; bf16_t* dst;
        if (r < 5632) { const int j = r / 2816; r -= j * 2816; kt = r / 176; nt = r - kt * 176;
            src = P.in(I_FFNIN) + (size_t)(l * 2 + j) * DM * (2 * DFF); ldsrc = 2 * DFF; K = DM;
            const int n0 = nt * 32, pn = n0 >> 8, bj = (n0 >> 7) & 1, i0 = n0 & 127; scol0 = bj * DFF + pn * 128 + i0;
            dst = (bf16_t*)(wl + WO_FI + (size_t)j * FI_BYTES); }
        else if (r < 8448) { r -= 5632; const int j = r / 1408; r -= j * 1408; kt = r / 32; nt = r - kt * 32;
            src = P.in(I_FFNOUT) + (size_t)(l * 2 + j) * DFF * DM; ldsrc = DM; K = DFF; scol0 = nt * 32;
            dst = (bf16_t*)(wl + WO_FO + (size_t)j * FO_BYTES); }
        else if (r < 9984) { r -= 8448; kt = r / 96; nt = r - kt * 96;
            src = P.in(I_WIN) + (size_t)l * DM * INC; ldsrc = INC; K = DM; scol0 = nt * 32; nvalid = INC - nt * 32;
            dst = (bf16_t*)(wl + WO_WIN); }
        else if (r < 10496) { r -= 9984; kt = r / 32; nt = r - kt * 32;
            src = P.in(I_WOUT) + (size_t)l * DM * DM; ldsrc = DM; K = DM; scol0 = nt * 32;
            dst = (bf16_t*)(wl + WO_WOUT); }
        else { r -= 10496; kt = r / 8; nt = r - kt * 8;
            src = P.in(I_GLUW) + (size_t)l * 65536; ldsrc = 256; K = 256; scol0 = nt * 32;
            dst = (bf16_t*)(wl + WO_GLU); }
        cvt_item(src + (size_t)kt * 64 * ldsrc, ldsrc, scol0, nvalid, dst + (size_t)nt * 32 * K + kt * 64, K, scr, lane);
    }
    __syncthreads();
    LAS float* sc = (LAS float*)lds;
    for (int i = tid; i < 33 * DM; i += NTHREADS) { const int bb = i >> 10, k = i & 1023; const float v = bb < 32 ? P.in(I_C)[bb * DM + k] : P.in(I_CCTX)[k]; sc[i] = siluf_(v); }
    __syncthreads();
    float* part = (float*)(P.ws() + WS_MODP);
    for (int it = gw; it < 2 * 144 * 8; it += nw) {
        const int l = it / 1152, r = it - l * 1152, jc = r >> 3, ks = r & 7, col = jc * 64 + lane;
        const float* W = P.in(I_MODW) + (size_t)l * DM * MODW + (size_t)(ks * 128) * MODW + col;
        float acc[33];
#pragma unroll
        for (int q = 0; q < 33; ++q) acc[q] = 0.f;
#pragma unroll 2
        for (int k8 = 0; k8 < 16; ++k8) {
            float w[8];
#pragma unroll
            for (int e = 0; e < 8; ++e) w[e] = W[(size_t)(8 * k8 + e) * MODW];
#pragma unroll
            for (int q = 0; q < 33; ++q) {
                const f32x4 s0 = *(const LAS f32x4*)(sc + q * DM + ks * 128 + 8 * k8), s1 = *(const LAS f32x4*)(sc + q * DM + ks * 128 + 8 * k8 + 4);
                acc[q] += (s0.x * w[0] + s0.y * w[1]) + (s0.z * w[2] + s0.w * w[3]) + (s1.x * w[4] + s1.y * w[5]) + (s1.z * w[6] + s1.w * w[7]);
            }
        }
#pragma unroll
        for (int q = 0; q < 33; ++q) part[((size_t)(l * 8 + ks) * 33 + q) * MODW + col] = acc[q];
    }
    __syncthreads();
}
__device__ __forceinline__ void modreduce_phase(const KP P, int gtid, int nthr) {
    const float* part = (const float*)(P.ws() + WS_MODP); float* modo = (float*)(P.ws() + WS_MOD);
    for (int i = gtid; i < 2 * 33 * MODW / 4; i += nthr) {
        const int e = i * 4, l = e / (33 * MODW), r = e - l * 33 * MODW, col = r % MODW;
        f32x4 a = *(const f32x4*)(P.in(I_MODB) + l * MODW + col);
#pragma unroll
        for (int ks = 0; ks < 8; ++ks) a += *(const f32x4*)(part + (size_t)(l * 8 + ks) * 33 * MODW + r);
        *(f32x4*)(modo + e) = a;
    }
    if (gtid < 512) {
        float* lbt = (float*)(P.ws() + WS_LB);
        lbt[gtid] = frcp(1.0f + __expf(P.in(I_HGLB)[gtid] - P.in(I_HGLB)[512 + gtid]));
    }
}

__device__ __forceinline__ void norm_phase(const float* hlat, const float* hctx, const float* modl, int ish, int isc, bf16_t* u, int nrows, int gw, int nw, int lane) {
    for (int row = gw; row < nrows; row += nw) {
        const float* src = row < MLAT ? hlat + (size_t)row * DM : hctx + (size_t)(row - MLAT) * DM;
        const int mrow = row < MLAT ? (row >> 11) : 32;
        const float* sh = modl + (size_t)mrow * MODW + ish * DM; const float* sl = modl + (size_t)mrow * MODW + isc * DM;
        f32x4 v[4]; float ss = 0.f;
#pragma unroll
        for (int i = 0; i < 2; ++i) { v[2 * i] = *(const f32x4*)(src + lane * 8 + 512 * i); v[2 * i + 1] = *(const f32x4*)(src + lane * 8 + 512 * i + 4); }
#pragma unroll
        for (int i = 0; i < 4; ++i) ss += (v[i].x * v[i].x + v[i].y * v[i].y) + (v[i].z * v[i].z + v[i].w * v[i].w);
        const float rstd = rsqrtf(wave_sum(ss, lane) * (1.0f / DM) + EPS);
#pragma unroll
        for (int i = 0; i < 2; ++i) {
            const int c = lane * 8 + 512 * i;
            const f32x4 s0 = *(const f32x4*)(sl + c), s1 = *(const f32x4*)(sl + c + 4), h0 = *(const f32x4*)(sh + c), h1 = *(const f32x4*)(sh + c + 4);
            const f32x4 a = v[2 * i] * rstd * (s0 + 1.0f) + h0, b = v[2 * i + 1] * rstd * (s1 + 1.0f) + h1;
            u32x4 w; w.x = pkbf(a.x, a.y); w.y = pkbf(a.z, a.w); w.z = pkbf(b.x, b.y); w.w = pkbf(b.z, b.w);
            *(u32x4*)(u + (size_t)row * DM + c) = w;
        }
    }
}
__device__ __forceinline__ void prep_phase(const KP P, LAS unsigned char* lds, int tid, int gw, int nw, int lane) {
    const float* mod0 = (const float*)(P.ws() + WS_MOD);
    bf16_t* xs = (bf16_t*)(P.ws() + WS_U); float* SS = (float*)(P.ws() + WS_SS);
    for (int row0 = gw; row0 < MALL; row0 += 2 * nw) {
        f32x4 v[2][4]; bool has[2]; int rw[2];
#pragma unroll
        for (int r = 0; r < 2; ++r) { const int rr = row0 + r * nw; has[r] = rr < MALL; rw[r] = has[r] ? rr : row0;
            const float* src = rw[r] < MLAT ? P.in(I_X) + (size_t)rw[r] * DM : P.in(I_CTX) + (size_t)(rw[r] - MLAT) * DM;
#pragma unroll
            for (int i = 0; i < 2; ++i) { v[r][2 * i] = *(const f32x4*)(src + lane * 8 + 512 * i); v[r][2 * i + 1] = *(const f32x4*)(src + lane * 8 + 512 * i + 4); } }
        __builtin_amdgcn_sched_barrier(0);
#pragma unroll
        for (int r = 0; r < 2; ++r) {
            const int row = rw[r];
            const int mrow = row < MLAT ? (row >> 11) : 32;
            const float* sl = mod0 + (size_t)mrow * MODW + 1 * DM;
            float ss = 0.f;
#pragma unroll
            for (int i = 0; i < 2; ++i) {
                const int c = lane * 8 + 512 * i;
                const f32x4 v0 = v[r][2 * i], v1 = v[r][2 * i + 1], s0 = *(const f32x4*)(sl + c) + 1.0f, s1 = *(const f32x4*)(sl + c + 4) + 1.0f;
                ss += (v0.x * v0.x + v0.y * v0.y) + (v0.z * v0.z + v0.w * v0.w) + (v1.x * v1.x + v1.y * v1.y) + (v1.z * v1.z + v1.w * v1.w);
                const f32x4 a = v0 * s0, b = v1 * s1;
                u32x4 w; w.x = pkbf(a.x, a.y); w.y = pkbf(a.z, a.w); w.z = pkbf(b.x, b.y); w.w = pkbf(b.z, b.w);
                if (has[r]) *(u32x4*)(xs + (size_t)row * DM + c) = w;
            }
            ss = wave_sum(ss, lane);
            if (has[r] && lane < 4) *(f32x4*)(SS + (size_t)row * 16 + lane * 4) = (f32x4){lane == 0 ? ss : 0.f, 0.f, 0.f, 0.f};
        }
    }
    LAS float* sh = (LAS float*)lds;
    float* BT = (float*)(P.ws() + WS_BIAS);
    const int wid = tid >> 6;
    for (int lt = 0; lt < 6; ++lt) {
        const int l = lt / 3, t = lt - 3 * l, N = t == 1 ? INCP : 2 * DFF;
        const float* modl = mod0 + (size_t)l * 33 * MODW + (3 * t) * DM;
        __syncthreads();
        for (int i = tid; i < 33 * DM; i += NTHREADS) sh[i] = modl[(size_t)(i >> 10) * MODW + (i & 1023)];
        __syncthreads();
        const bf16_t* Bt = (const bf16_t*)(P.ws() + WS_W + (size_t)l * W_LAYER + (t == 0 ? WO_FI : (t == 1 ? WO_WIN : WO_FI + FI_BYTES)));
        float* out = BT + (size_t)lt * BIAS_TAB;
        for (int n = blockIdx.x * 8 + wid; n < N; n += nw) {
            float w[16];
            unpack8(*(const u32x4*)(Bt + (size_t)n * DM + lane * 16), w); unpack8(*(const u32x4*)(Bt + (size_t)n * DM + lane * 16 + 8), w + 8);
            float keep = 0.f;
#pragma unroll 1
            for (int q = 0; q < 33; ++q) {
                const LAS float* s = sh + q * DM + lane * 16;
                const f32x4 a = *(const LAS f32x4*)s, b = *(const LAS f32x4*)(s + 4), c = *(const LAS f32x4*)(s + 8), d = *(const LAS f32x4*)(s + 12);
                float acc = (a.x * w[0] + a.y * w[1]) + (a.z * w[2] + a.w * w[3]) + (b.x * w[4] + b.y * w[5]) + (b.z * w[6] + b.w * w[7])
                          + (c.x * w[8] + c.y * w[9]) + (c.z * w[10] + c.w * w[11]) + (d.x * w[12] + d.y * w[13]) + (d.z * w[14] + d.w * w[15]);
                acc = wave_sum(acc, lane);
                if (lane == q) keep = acc;
            }
            if (lane < 33) out[(size_t)lane * BIAS_LD + n] = keep;
        }
    }
    __syncthreads();
}

template <class Sched> __device__ __forceinline__ void rstd_prestep(const Sched& S, const float* SS, LAS unsigned char* lds, int tid) {
    LAS float* R = (LAS float*)(lds + 131072);
    pg8::Unit u;
    for (int i = 0; S.next(i, u); ++i) if (tid < 256) R[i * 256 + tid] = pg8::row_rstd(SS, (size_t)u.pm * 256 + tid);
    __syncthreads();
}

__device__ __forceinline__ void final_phase(float* out, const float* fw, int gw, int nw, int lane) {
    f32x4 w[4];
#pragma unroll
    for (int i = 0; i < 4; ++i) w[i] = *(const f32x4*)(fw + lane * 4 + 256 * i);
    for (int row = gw; row < MLAT; row += 3 * nw) {
        f32x4 v[3][4]; bool has[3];
#pragma unroll
        for (int r = 0; r < 3; ++r) { const int rr = row + r * nw; has[r] = rr < MLAT; const float* src = out + (size_t)(has[r] ? rr : row) * DM;
#pragma unroll
            for (int i = 0; i < 4; ++i) v[r][i] = *(const f32x4*)(src + lane * 4 + 256 * i); }
        __builtin_amdgcn_sched_barrier(0);
#pragma unroll
        for (int r = 0; r < 3; ++r) {
            float ss = 0.f;
#pragma unroll
            for (int i = 0; i < 4; ++i) ss += (v[r][i].x * v[r][i].x + v[r][i].y * v[r][i].y) + (v[r][i].z * v[r][i].z + v[r][i].w * v[r][i].w);
            const float rstd = rsqrtf(wave_sum(ss, lane) * (1.0f / DM) + EPS);
            if (has[r]) { float* dst = out + (size_t)(row + r * nw) * DM;
#pragma unroll
                for (int i = 0; i < 4; ++i) *(f32x4*)(dst + lane * 4 + 256 * i) = v[r][i] * rstd * w[i]; }
        }
    }
}

struct ConvIn { u32x4 x[5]; };
__device__ __forceinline__ ConvIn conv_load(const bf16_t* p, int row, int ch, bool colmajor) {
    ConvIn r;
    const bool lat = row < MLAT;
    int s, L, base;
    if (lat) { const int tok = row & 2047; s = colmajor ? ((tok & 63) * 32 + (tok >> 6)) : tok; L = SEQ; base = row & ~2047; }
    else { const int r2 = row - MLAT; s = r2 & 255; L = CTXL; base = MLAT + (r2 & ~255); }
#pragma unroll
    for (int d = 0; d < 5; ++d) {
        const int sp = s + d - 2;
        r.x[d] = (u32x4){0u, 0u, 0u, 0u};
        if (sp >= 0 && sp < L) { const int tokp = (lat && colmajor) ? ((sp & 31) * 64 + (sp >> 5)) : sp; r.x[d] = *(const u32x4*)(p + (size_t)(base + tokp) * INC + PC_XBC + ch); }
    }
    return r;
}
__device__ __forceinline__ void conv_item(const ConvIn& r, bf16_t* cv, const float* cw, const float* cb, int row, int ch) {
    float acc[8];
    { const f32x4 b0 = *(const f32x4*)(cb + ch), b1 = *(const f32x4*)(cb + ch + 4); acc[0] = b0.x; acc[1] = b0.y; acc[2] = b0.z; acc[3] = b0.w; acc[4] = b1.x; acc[5] = b1.y; acc[6] = b1.z; acc[7] = b1.w; }
#pragma unroll
    for (int d = 0; d < 5; ++d) {
        float xf[8]; unpack8(r.x[d], xf);
        const f32x4 w0 = *(const f32x4*)(cw + d * 768 + ch), w1 = *(const f32x4*)(cw + d * 768 + ch + 4);
        acc[0] += w0.x * xf[0]; acc[1] += w0.y * xf[1]; acc[2] += w0.z * xf[2]; acc[3] += w0.w * xf[3];
        acc[4] += w1.x * xf[4]; acc[5] += w1.y * xf[5]; acc[6] += w1.z * xf[6]; acc[7] += w1.w * xf[7];
    }
    u32x4 w; w.x = pkbf(siluf_(acc[0]), siluf_(acc[1])); w.y = pkbf(siluf_(acc[2]), siluf_(acc[3])); w.z = pkbf(siluf_(acc[4]), siluf_(acc[5])); w.w = pkbf(siluf_(acc[6]), siluf_(acc[7]));
    *(u32x4*)(cv + (size_t)row * 768 + ch) = w;
}
__device__ __forceinline__ void conv_phase(const bf16_t* p, bf16_t* cv, const float* cw, const float* cb, bool colmajor, int gtid, int nthr) {
    for (int idx = gtid; idx < MALL * 96; idx += 4 * nthr) {
        ConvIn in[4]; int row[4], ch[4]; bool has[4];
#pragma unroll
        for (int r = 0; r < 4; ++r) { const int i = idx + r * nthr; has[r] = i < MALL * 96; const int j = has[r] ? i : idx; row[r] = j / 96; ch[r] = (j - row[r] * 96) * 8; in[r] = conv_load(p, row[r], ch[r], colmajor); }
        __builtin_amdgcn_sched_barrier(0);
#pragma unroll
        for (int r = 0; r < 4; ++r) if (has[r]) conv_item(in[r], cv, cw, cb, row[r], ch[r]);
    }
}

__device__ __forceinline__ int seq_row(int b, int dir, int i, bool colmajor) {
    if (i < CTXL) { const int s = dir ? (CTXL - 1 - i) : i; return MLAT + b * CTXL + s; }
    int s = i - CTXL; if (dir) s = SEQ - 1 - s;
    const int tok = colmajor ? ((s & 31) * 64 + (s >> 5)) : s;
    return b * SEQ + tok;
}

template <bool HG>
__device__ __forceinline__ void scan_mat(const KP P, int l, int un, LAS float* wl, int lane) {
    int b, dir, h, half;
    if (!HG) { b = un >> 5; dir = (un >> 4) & 1; h = (un >> 1) & 7; half = un & 1; }
    else { b = un >> 4; dir = (un >> 3) & 1; h = (un >> 1) & 3; half = un & 1; }
    const bool colmajor = (l & 1) != 0;
    const bf16_t* p = (const bf16_t*)(P.ws() + WS_P); const bf16_t* cv = (const bf16_t*)(P.ws() + WS_U);
    bf16_t* Y = (bf16_t*)(P.ws() + (dir ? WS_YB : WS_YF));
    LAS float* Fb = wl; LAS float* Bb = wl + 1024; LAS float* Cb = wl + 2048; LAS float* Xb = wl + 3072; LAS float* Ob = wl + 3584;
    const int si = lane >> 2, part = lane & 3, pg = lane >> 3, ng = lane & 7;
    float dtb = 0.f, aneg = 0.f, dsk = 0.f; float oml[16];
    if (!HG) { dtb = P.in(I_DTB)[(l * 2 + dir) * 8 + h]; aneg = -__expf(P.in(I_ALOG)[(l * 2 + dir) * 8 + h]); dsk = dir == 0 ? P.in(I_AD)[l * 8 + h] : 0.f; }
#pragma unroll
    for (int j = 0; j < 16; ++j) {
        float lb = 0.f;
        if (HG && l == 1) { const int idx = dir * 256 + h * 64 + part * 16 + j; lb = frcp(1.0f + __expf(P.in(I_HGLB)[idx] - P.in(I_HGLB)[512 + idx])); }
        oml[j] = 1.0f - lb;
    }
    const int colbase = HG ? (768 + h * 64 + half * 32 + part * 8) : (h * 64 + half * 32 + part * 8);
    f32x2 S[4][4];
#pragma unroll
    for (int a = 0; a < 4; ++a)
#pragma unroll
        for (int c = 0; c < 4; ++c) S[a][c] = (f32x2){0.f, 0.f};
    u32x4 r0, r1, r2, r3, r4; bf16_t rdt = 0; int rown;
#define SCAN_LOAD(ch) do { rown = seq_row(b, dir, (ch) * 16 + si, colmajor); \
        if (!HG) { const bf16_t* cr = cv + (size_t)rown * 768; r0 = *(const u32x4*)(cr + h * 64 + half * 32 + part * 8); \
            r1 = *(const u32x4*)(cr + 512 + (h >> 2) * 64 + part * 16); r2 = *(const u32x4*)(cr + 512 + (h >> 2) * 64 + part * 16 + 8); \
            r3 = *(const u32x4*)(cr + 640 + (h >> 2) * 64 + part * 16); r4 = *(const u32x4*)(cr + 640 + (h >> 2) * 64 + part * 16 + 8); \
            rdt = p[(size_t)rown * INC + PC_DT + dir * 8 + h]; } \
        else { const bf16_t* pr = p + (size_t)rown * INC; r0 = *(const u32x4*)(pr + PC_I + h * 64 + half * 32 + part * 8); \
            r1 = *(const u32x4*)(pr + PC_F + dir * 256 + h * 64 + part * 16); r2 = *(const u32x4*)(pr + PC_F + dir * 256 + h * 64 + part * 16 + 8); \
            r3 = *(const u32x4*)(pr + PC_Q + h * 64 + part * 16); r4 = *(const u32x4*)(pr + PC_Q + h * 64 + part * 16 + 8); } } while (0)
    SCAN_LOAD(0);
    for (int ch = 0; ch < NSTEP / 16; ++ch) {
        const int rowc = rown;
        {
            float t[16];
            unpack8(r0, t);
            *(LAS f32x4*)(Xb + si * 32 + part * 8) = (f32x4){t[0], t[1], t[2], t[3]}; *(LAS f32x4*)(Xb + si * 32 + part * 8 + 4) = (f32x4){t[4], t[5], t[6], t[7]};
            unpack8(r1, t); unpack8(r2, t + 8);
            if (!HG) {
#pragma unroll
                for (int q = 0; q < 4; ++q) *(LAS f32x4*)(Bb + si * 64 + part * 16 + 4 * q) = (f32x4){t[4 * q], t[4 * q + 1], t[4 * q + 2], t[4 * q + 3]};
                if (part == 0) { const float xr = bf1(rdt) + dtb; const float dt = fmaxf(xr, 0.f) + log1pf(__expf(-fabsf(xr))); *(LAS f32x2*)(Fb + si * 64) = (f32x2){__expf(dt * aneg), dt}; }
            } else {
                float kk[16], ff[16];
#pragma unroll
                for (int j = 0; j < 16; ++j) { kk[j] = oml[j] * frcp(1.0f + __expf(t[j])); ff[j] = 1.0f - kk[j]; }
#pragma unroll
                for (int q = 0; q < 4; ++q) { *(LAS f32x4*)(Bb + si * 64 + part * 16 + 4 * q) = (f32x4){kk[4 * q], kk[4 * q + 1], kk[4 * q + 2], kk[4 * q + 3]};
                    *(LAS f32x4*)(Fb + si * 64 + part * 16 + 4 * q) = (f32x4){ff[4 * q], ff[4 * q + 1], ff[4 * q + 2], ff[4 * q + 3]}; }
            }
            unpack8(r3, t); unpack8(r4, t + 8);
            if (HG) {
#pragma unroll
                for (int j = 0; j < 16; ++j) t[j] = siluf_(t[j]);
            }
#pragma unroll
            for (int q = 0; q < 4; ++q) *(LAS f32x4*)(Cb + si * 64 + part * 16 + 4 * q) = (f32x4){t[4 * q], t[4 * q + 1], t[4 * q + 2], t[4 * q + 3]};
        }
        if (ch + 1 < NSTEP / 16) SCAN_LOAD(ch + 1);
#pragma unroll 2
        for (int s = 0; s < 16; ++s) {
            const f32x4 x4 = *(const LAS f32x4*)(Xb + s * 32 + pg * 4);
            const f32x4 b0 = *(const LAS f32x4*)(Bb + s * 64 + ng * 8), b1 = *(const LAS f32x4*)(Bb + s * 64 + ng * 8 + 4);
            const f32x4 c0 = *(const LAS f32x4*)(Cb + s * 64 + ng * 8), c1 = *(const LAS f32x4*)(Cb + s * 64 + ng * 8 + 4);
            f32x2 fv[4]; f32x4 xs = x4;
            if (!HG) { const f32x2 dd = *(const LAS f32x2*)(Fb + s * 64); fv[0] = fv[1] = fv[2] = fv[3] = (f32x2){dd.x, dd.x}; xs = x4 * dd.y; }
            else { const f32x4 f0 = *(const LAS f32x4*)(Fb + s * 64 + ng * 8), f1 = *(const LAS f32x4*)(Fb + s * 64 + ng * 8 + 4);
                fv[0] = (f32x2){f0.x, f0.y}; fv[1] = (f32x2){f0.z, f0.w}; fv[2] = (f32x2){f1.x, f1.y}; fv[3] = (f32x2){f1.z, f1.w}; }
            const f32x2 bv[4] = {(f32x2){b0.x, b0.y}, (f32x2){b0.z, b0.w}, (f32x2){b1.x, b1.y}, (f32x2){b1.z, b1.w}};
            const f32x2 cq[4] = {(f32x2){c0.x, c0.y}, (f32x2){c0.z, c0.w}, (f32x2){c1.x, c1.y}, (f32x2){c1.z, c1.w}};
            float y[4];
#pragma unroll
            for (int pi = 0; pi < 4; ++pi) {
                const f32x2 xx = (f32x2){xs[pi], xs[pi]};
                f32x2 a2 = (f32x2){0.f, 0.f};
#pragma unroll
                for (int q = 0; q < 4; ++q) { S[pi][q] = fv[q] * S[pi][q] + xx * bv[q]; a2 += S[pi][q] * cq[q]; }
                float yy = a2.x + a2.y;
                yy += dpp_f<0xB1>(yy); yy += dpp_f<0x4E>(yy); yy += dpp_f<0x141>(yy);
                y[pi] = yy;
            }
            if (ng == 0) { f32x4 yo = (f32x4){y[0], y[1], y[2], y[3]}; if (!HG) yo += x4 * dsk; *(LAS f32x4*)(Ob + s * 32 + pg * 4) = yo; }
        }
        {
            const f32x4 o0 = *(const LAS f32x4*)(Ob + si * 32 + part * 8), o1 = *(const LAS f32x4*)(Ob + si * 32 + part * 8 + 4);
            u32x4 w; w.x = pkbf(o0.x, o0.y); w.y = pkbf(o0.z, o0.w); w.z = pkbf(o1.x, o1.y); w.w = pkbf(o1.z, o1.w);
            *(u32x4*)(Y + (size_t)rowc * DM + colbase) = w;
        }
    }
#undef SCAN_LOAD
}

__device__ __forceinline__ bf16x8 as_bf8(u32x4 v) { return __builtin_bit_cast(bf16x8, v); }
__device__ __forceinline__ void ssd_mfma_unit(const KP P, int l, int un, LAS unsigned char* wlb, int lane) {
    const int b = un >> 5, dir = (un >> 4) & 1, h = (un >> 1) & 7, half = un & 1, g = h >> 2;
    const bool colmajor = (l & 1) != 0;
    const bf16_t* p = (const bf16_t*)(P.ws() + WS_P); const bf16_t* cv = (const bf16_t*)(P.ws() + WS_U);
    bf16_t* Y = (bf16_t*)(P.ws() + (dir ? WS_YB : WS_YF));
    LAS bf16_t* XL = (LAS bf16_t*)wlb;
    LAS bf16_t* BL = (LAS bf16_t*)(wlb + 4096);
    LAS bf16_t* SL = (LAS bf16_t*)(wlb + 12288);
    LAS float* cumL = (LAS float*)(wlb + 20992); LAS float* dtL = cumL + 64; LAS float* wL = cumL + 128;
    const int li = lane & 15, quad = lane >> 4;
    const float dtb = P.in(I_DTB)[(l * 2 + dir) * 8 + h], aneg = -__expf(P.in(I_ALOG)[(l * 2 + dir) * 8 + h]), dsk = dir == 0 ? P.in(I_AD)[l * 8 + h] : 0.f;
    f32x4 Sacc[2][4];
#pragma unroll
    for (int a = 0; a < 2; ++a)
#pragma unroll
        for (int c = 0; c < 4; ++c) Sacc[a][c] = (f32x4){0.f, 0.f, 0.f, 0.f};
    for (int i = lane; i < 32 * 136 / 2; i += 64) ((LAS unsigned*)SL)[i] = 0u;
    const int ycol = h * 64 + half * 32;
    asm volatile("" ::: "memory");
    bf16_t rdt; u32x4 xq[4]; u32x4 fB[4][2], fC[4][2]; int rr[4];
#define SSD_LOAD_A(ch) do { const int rt_ = seq_row(b, dir, (ch) * 64 + lane, colmajor); rdt = p[(size_t)rt_ * INC + PC_DT + dir * 8 + h]; \
        const bf16_t* xrow_ = cv + (size_t)rt_ * 768 + ycol; _Pragma("unroll") for (int q = 0; q < 4; ++q) xq[q] = *(const u32x4*)(xrow_ + q * 8); } while (0)
#define SSD_LOAD_B(ch) do { _Pragma("unroll") for (int t = 0; t < 4; ++t) { rr[t] = seq_row(b, dir, (ch) * 64 + 16 * t + li, colmajor); \
        _Pragma("unroll") for (int ks = 0; ks < 2; ++ks) { const bf16_t* cr_ = cv + (size_t)rr[t] * 768 + g * 64 + 32 * ks + quad * 8; fB[t][ks] = *(const u32x4*)(cr_ + 512); fC[t][ks] = *(const u32x4*)(cr_ + 640); } } } while (0)
    SSD_LOAD_A(0); SSD_LOAD_B(0);
#pragma unroll 1
    for (int ch = 0; ch < NSTEP / 64; ++ch) {
        {
            const float xr = bf1(rdt) + dtb;
            const float dt = fmaxf(xr, 0.f) + log1pf(__expf(-fabsf(xr)));
            float cum = dt * aneg;
#pragma unroll
            for (int o = 1; o < 64; o <<= 1) { const float t = __builtin_bit_cast(float, __builtin_amdgcn_ds_bpermute((lane - o) << 2, __builtin_bit_cast(int, cum))); if (lane >= o) cum += t; }
            const float cum63 = __builtin_bit_cast(float, __builtin_amdgcn_readlane(__builtin_bit_cast(int, cum), 63));
            cumL[lane] = cum; dtL[lane] = dt; wL[lane] = __expf(cum63 - cum) * dt;
#pragma unroll
            for (int q = 0; q < 4; ++q) *(LAS u32x4*)(XL + lane * 32 + q * 8) = xq[q];
            const float dall = __expf(cum63);
#pragma unroll
            for (int a = 0; a < 2; ++a)
#pragma unroll
                for (int c = 0; c < 4; ++c) Sacc[a][c] = Sacc[a][c] * dall;
        }
#pragma unroll
        for (int t = 0; t < 4; ++t)
#pragma unroll
            for (int ks = 0; ks < 2; ++ks) *(LAS u32x4*)(BL + (16 * t + li) * 64 + 32 * ks + quad * 8) = fB[t][ks];
        asm volatile("" ::: "memory");
        float ci[4];
#pragma unroll
        for (int it = 0; it < 4; ++it) ci[it] = cumL[16 * it + li];
        __builtin_amdgcn_sched_barrier(0);
        u32x4 Mf[4][2];
#pragma unroll
        for (int it = 0; it < 4; ++it) { Mf[it][0] = (u32x4){0u, 0u, 0u, 0u}; Mf[it][1] = (u32x4){0u, 0u, 0u, 0u}; }
#pragma unroll
        for (int jt = 0; jt < 4; ++jt) {
            const f32x4 cj = *(const LAS f32x4*)(cumL + 16 * jt + quad * 4), dj = *(const LAS f32x4*)(dtL + 16 * jt + quad * 4);
#pragma unroll
            for (int it = jt; it < 4; ++it) {
                f32x4 acc = (f32x4){0.f, 0.f, 0.f, 0.f};
                acc = __builtin_amdgcn_mfma_f32_16x16x32_bf16(as_bf8(fB[jt][0]), as_bf8(fC[it][0]), acc, 0, 0, 0);
                acc = __builtin_amdgcn_mfma_f32_16x16x32_bf16(as_bf8(fB[jt][1]), as_bf8(fC[it][1]), acc, 0, 0, 0);
                float v[4];
#pragma unroll
                for (int jj = 0; jj < 4; ++jj) {
                    float m = acc[jj] * __expf(ci[it] - cj[jj]) * dj[jj];
                    if (jt == it && (quad * 4 + jj) > li) m = 0.f;
                    v[jj] = m;
                }
                const unsigned lo = pkbf(v[0], v[1]), hi = pkbf(v[2], v[3]);
                if (jt & 1) { Mf[it][jt >> 1].z = lo; Mf[it][jt >> 1].w = hi; } else { Mf[it][jt >> 1].x = lo; Mf[it][jt >> 1].y = hi; }
            }
        }
        unsigned xg[2][2][8]; u32x4 Sf[2][2];
#pragma unroll
        for (int pt = 0; pt < 2; ++pt)
#pragma unroll
            for (int ks2 = 0; ks2 < 2; ++ks2)
#pragma unroll
                for (int e = 0; e < 8; ++e) xg[pt][ks2][e] = XL[(32 * ks2 + 16 * (e >> 2) + quad * 4 + (e & 3)) * 32 + 16 * pt + li];
#pragma unroll
        for (int pt = 0; pt < 2; ++pt)
#pragma unroll
            for (int ks = 0; ks < 2; ++ks) Sf[pt][ks] = *(const LAS u32x4*)(SL + (16 * pt + li) * 136 + 32 * ks + quad * 8);
        __builtin_amdgcn_sched_barrier(0);
        u32x4 XT[2][2];
#pragma unroll
        for (int pt = 0; pt < 2; ++pt)
#pragma unroll
            for (int ks2 = 0; ks2 < 2; ++ks2)
                XT[pt][ks2] = (u32x4){xg[pt][ks2][0] | (xg[pt][ks2][1] << 16), xg[pt][ks2][2] | (xg[pt][ks2][3] << 16), xg[pt][ks2][4] | (xg[pt][ks2][5] << 16), xg[pt][ks2][6] | (xg[pt][ks2][7] << 16)};
#pragma unroll
        for (int it = 0; it < 4; ++it) {
            const float eci = __expf(ci[it]);
#pragma unroll
            for (int pt = 0; pt < 2; ++pt) {
                f32x4 acc = (f32x4){0.f, 0.f, 0.f, 0.f}, acc2 = (f32x4){0.f, 0.f, 0.f, 0.f};
#pragma unroll
                for (int ks2 = 0; ks2 < 2; ++ks2) if (2 * ks2 <= it) acc = __builtin_amdgcn_mfma_f32_16x16x32_bf16(as_bf8(XT[pt][ks2]), as_bf8(Mf[it][ks2]), acc, 0, 0, 0);
#pragma unroll
                for (int ks = 0; ks < 2; ++ks) acc2 = __builtin_amdgcn_mfma_f32_16x16x32_bf16(as_bf8(Sf[pt][ks]), as_bf8(fC[it][ks]), acc2, 0, 0, 0);
                const u32x2 xw = *(const LAS u32x2*)(XL + (16 * it + li) * 32 + 16 * pt + quad * 4);
                acc = acc + acc2 * eci;
                acc[0] += dsk * bf_lo(xw.x); acc[1] += dsk * bf_hi(xw.x); acc[2] += dsk * bf_lo(xw.y); acc[3] += dsk * bf_hi(xw.y);
                u32x2 o; o.x = pkbf(acc[0], acc[1]); o.y = pkbf(acc[2], acc[3]);
                *(u32x2*)(Y + (size_t)rr[it] * DM + ycol + 16 * pt + quad * 4) = o;
            }
        }
        if (ch + 1 < NSTEP / 64) { SSD_LOAD_A(ch + 1); SSD_LOAD_B(ch + 1); }
        f32x4 w0[2], w1[2];
#pragma unroll
        for (int ks2 = 0; ks2 < 2; ++ks2) { w0[ks2] = *(const LAS f32x4*)(wL + 32 * ks2 + quad * 4); w1[ks2] = *(const LAS f32x4*)(wL + 32 * ks2 + 16 + quad * 4); }
#pragma unroll
        for (int nh = 0; nh < 2; ++nh) {
            unsigned bg[2][2][8];
#pragma unroll
            for (int n2 = 0; n2 < 2; ++n2)
#pragma unroll
                for (int ks2 = 0; ks2 < 2; ++ks2)
#pragma unroll
                    for (int e = 0; e < 8; ++e) bg[n2][ks2][e] = BL[(32 * ks2 + 16 * (e >> 2) + quad * 4 + (e & 3)) * 64 + 16 * (2 * nh + n2) + li];
            __builtin_amdgcn_sched_barrier(0);
#pragma unroll
            for (int n2 = 0; n2 < 2; ++n2)
#pragma unroll
                for (int ks2 = 0; ks2 < 2; ++ks2) {
                    float v[8];
#pragma unroll
                    for (int e = 0; e < 8; ++e) v[e] = __builtin_bit_cast(float, bg[n2][ks2][e] << 16) * ((e < 4) ? w0[ks2][e & 3] : w1[ks2][e & 3]);
                    const u32x4 bw = (u32x4){pkbf(v[0], v[1]), pkbf(v[2], v[3]), pkbf(v[4], v[5]), pkbf(v[6], v[7])};
#pragma unroll
                    for (int pt = 0; pt < 2; ++pt) Sacc[pt][2 * nh + n2] = __builtin_amdgcn_mfma_f32_16x16x32_bf16(as_bf8(XT[pt][ks2]), as_bf8(bw), Sacc[pt][2 * nh + n2], 0, 0, 0);
                }
            __builtin_amdgcn_sched_barrier(0);
        }
#pragma unroll
        for (int pt = 0; pt < 2; ++pt)
#pragma unroll
            for (int nt = 0; nt < 4; ++nt) {
                const unsigned s01 = pkbf(Sacc[pt][nt][0], Sacc[pt][nt][1]), s23 = pkbf(Sacc[pt][nt][2], Sacc[pt][nt][3]);
                LAS bf16_t* sp = SL + (16 * pt + quad * 4) * 136 + 16 * nt + li;
                sp[0] = (bf16_t)(s01 & 0xffffu); sp[136] = (bf16_t)(s01 >> 16); sp[272] = (bf16_t)(s23 & 0xffffu); sp[408] = (bf16_t)(s23 >> 16);
            }
        asm volatile("" ::: "memory");
    }
#undef SSD_LOAD_A
#undef SSD_LOAD_B
}

__device__ __forceinline__ void hg_prepass(const KP P, int l, int gw, int nw, int lane) {
    bf16_t* p = (bf16_t*)(P.ws() + WS_P); bf16_t* qb = (bf16_t*)(P.ws() + WS_YBUF); float* E15 = (float*)(P.ws() + WS_MODP);
    const float* lbt = (const float*)(P.ws() + WS_LB);
    const bool colmajor = (l & 1) != 0;
    const int li = lane & 15, quad = lane >> 4;
    const int bid_ = gw >> 3, v_ = (bid_ & 7) * 32 + (bid_ >> 3), b = v_ >> 3, wib = (v_ & 7) * 8 + (gw & 7);
    for (int k9 = 0; k9 < 9; ++k9) {
        const int il = wib + k9 * 64, h = il & 3, blk = il >> 2;
        const int row = seq_row(b, 0, blk * 16 + li, colmajor);
        bf16_t* pr = p + (size_t)row * INC;
        u32x4 rq[2], rf[2], rb[2];
#pragma unroll
        for (int ks = 0; ks < 2; ++ks) { rq[ks] = *(const u32x4*)(pr + PC_Q + h * 64 + 32 * ks + quad * 8); rf[ks] = *(const u32x4*)(pr + PC_F + h * 64 + 32 * ks + quad * 8); rb[ks] = *(const u32x4*)(pr + PC_F + 256 + h * 64 + 32 * ks + quad * 8); }
        float omf[16], omb[16];
#pragma unroll
        for (int ks = 0; ks < 2; ++ks)
#pragma unroll
            for (int q4 = 0; q4 < 2; ++q4) {
                f32x4 a = (f32x4){0.f, 0.f, 0.f, 0.f}, c = a;
                if (l == 1) { a = *(const f32x4*)(lbt + h * 64 + 32 * ks + quad * 8 + 4 * q4); c = *(const f32x4*)(lbt + 256 + h * 64 + 32 * ks + quad * 8 + 4 * q4); }
#pragma unroll
                for (int j = 0; j < 4; ++j) { omf[8 * ks + 4 * q4 + j] = 1.0f - a[j]; omb[8 * ks + 4 * q4 + j] = 1.0f - c[j]; }
            }
        float qv[16], zf[16], zb[16];
        unpack8(rq[0], qv); unpack8(rq[1], qv + 8); unpack8(rf[0], zf); unpack8(rf[1], zf + 8); unpack8(rb[0], zb); unpack8(rb[1], zb + 8);
        float qf[16], kf[16], qbw[16], kb[16], ef[16], eb[16];
#pragma unroll
        for (int i = 0; i < 16; ++i) {
            const float sq = siluf_(qv[i]);
            {
                const float kk = omf[i] * frcp(1.0f + __expf(zf[i]));
                float L = __logf(1.0f - kk);
                L += dpp_f<0x111>(L); L += dpp_f<0x112>(L); L += dpp_f<0x114>(L); L += dpp_f<0x118>(L);
                L = fmaxf(L, -60.0f);
                const float eL = __expf(L);
                qf[i] = sq * eL; kf[i] = kk * frcp(eL); ef[i] = eL;
            }
            {
                const float kk = omb[i] * frcp(1.0f + __expf(zb[i]));
                float L = __logf(1.0f - kk);
                L += dpp_f<0x101>(L); L += dpp_f<0x102>(L); L += dpp_f<0x104>(L); L += dpp_f<0x108>(L);
                L = fmaxf(L, -60.0f);
                const float eL = __expf(L);
                qbw[i] = sq * eL; kb[i] = kk * frcp(eL); eb[i] = eL;
            }
        }
        bf16_t* qbr = qb + (size_t)row * 256;
#pragma unroll
        for (int ks = 0; ks < 2; ++ks) {
            const int o = 8 * ks;
            *(u32x4*)(pr + PC_Q + h * 64 + 32 * ks + quad * 8) = (u32x4){pkbf(qf[o], qf[o + 1]), pkbf(qf[o + 2], qf[o + 3]), pkbf(qf[o + 4], qf[o + 5]), pkbf(qf[o + 6], qf[o + 7])};
            *(u32x4*)(pr + PC_F + h * 64 + 32 * ks + quad * 8) = (u32x4){pkbf(kf[o], kf[o + 1]), pkbf(kf[o + 2], kf[o + 3]), pkbf(kf[o + 4], kf[o + 5]), pkbf(kf[o + 6], kf[o + 7])};
            *(u32x4*)(pr + PC_F + 256 + h * 64 + 32 * ks + quad * 8) = (u32x4){pkbf(kb[o], kb[o + 1]), pkbf(kb[o + 2], kb[o + 3]), pkbf(kb[o + 4], kb[o + 5]), pkbf(kb[o + 6], kb[o + 7])};
            *(u32x4*)(qbr + h * 64 + 32 * ks + quad * 8) = (u32x4){pkbf(qbw[o], qbw[o + 1]), pkbf(qbw[o + 2], qbw[o + 3]), pkbf(qbw[o + 4], qbw[o + 5]), pkbf(qbw[o + 6], qbw[o + 7])};
        }
        if (li == 15) { float* e = E15 + ((size_t)(0 * 32 + b) * 144 + blk) * 256 + h * 64 + quad * 8;
#pragma unroll
            for (int ks = 0; ks < 2; ++ks) { *(f32x4*)(e + 32 * ks) = (f32x4){ef[8 * ks], ef[8 * ks + 1], ef[8 * ks + 2], ef[8 * ks + 3]}; *(f32x4*)(e + 32 * ks + 4) = (f32x4){ef[8 * ks + 4], ef[8 * ks + 5], ef[8 * ks + 6], ef[8 * ks + 7]}; } }
        if (li == 0) { float* e = E15 + ((size_t)(1 * 32 + b) * 144 + blk) * 256 + h * 64 + quad * 8;
#pragma unroll
            for (int ks = 0; ks < 2; ++ks) { *(f32x4*)(e + 32 * ks) = (f32x4){eb[8 * ks], eb[8 * ks + 1], eb[8 * ks + 2], eb[8 * ks + 3]}; *(f32x4*)(e + 32 * ks + 4) = (f32x4){eb[8 * ks + 4], eb[8 * ks + 5], eb[8 * ks + 6], eb[8 * ks + 7]}; } }
    }
}

__device__ __forceinline__ void hg_mfma_unit(const KP P, int l, int un, LAS unsigned char* wlb, int lane) {
    const int b = un >> 4, dir = (un >> 3) & 1, h = (un >> 1) & 3, vhalf = un & 1;
    const bool colmajor = (l & 1) != 0;
    const bf16_t* p = (const bf16_t*)(P.ws() + WS_P); const bf16_t* qb = (const bf16_t*)(P.ws() + WS_YBUF); const float* E15 = (const float*)(P.ws() + WS_MODP);
    bf16_t* Y = (bf16_t*)(P.ws() + (dir ? WS_YB : WS_YF));
    LAS bf16_t* VL = (LAS bf16_t*)wlb;
    LAS bf16_t* KL = (LAS bf16_t*)(wlb + 1024);
    LAS bf16_t* SL = (LAS bf16_t*)(wlb + 3072);
    const int li = lane & 15, quad = lane >> 4;
    f32x4 Sacc[2][4];
#pragma unroll
    for (int a = 0; a < 2; ++a)
#pragma unroll
        for (int c = 0; c < 4; ++c) Sacc[a][c] = (f32x4){0.f, 0.f, 0.f, 0.f};
    for (int i = lane; i < 32 * 72 / 2; i += 64) ((LAS unsigned*)SL)[i] = 0u;
    asm volatile("" ::: "memory");
    const int ycol = 768 + h * 64 + vhalf * 32;
    u32x4 KfA[4][2], QfA[4][2], rvA[4]; float e15A[4][4]; int rownA[4];
#define HG_LOAD(ch, k) do { rownA[k] = seq_row(b, dir, (ch) * 16 + li, colmajor); const bf16_t* pr = p + (size_t)rownA[k] * INC; \
        const bf16_t* qs = dir ? qb + (size_t)rownA[k] * 256 + h * 64 + quad * 8 : pr + PC_Q + h * 64 + quad * 8; \
        KfA[k][0] = *(const u32x4*)(pr + PC_F + dir * 256 + h * 64 + quad * 8); KfA[k][1] = *(const u32x4*)(pr + PC_F + dir * 256 + h * 64 + 32 + quad * 8); \
        QfA[k][0] = *(const u32x4*)(qs); QfA[k][1] = *(const u32x4*)(qs + 32); \
        rvA[k] = *(const u32x4*)(pr + PC_I + h * 64 + vhalf * 32 + quad * 8); \
        const int blk_ = dir ? ((ch) < 16 ? 15 - (ch) : 159 - (ch)) : (ch); const float* ep = E15 + ((size_t)(dir * 32 + b) * 144 + blk_) * 256 + h * 64 + li; \
        e15A[k][0] = ep[0]; e15A[k][1] = ep[16]; e15A[k][2] = ep[32]; e15A[k][3] = ep[48]; } while (0)
#pragma unroll
    for (int k = 0; k < 4; ++k) HG_LOAD(k, k);
#pragma unroll 1
    for (int ch0 = 0; ch0 < NSTEP / 16; ch0 += 4) {
#pragma unroll
      for (int k = 0; k < 4; ++k) {
        const int ch = ch0 + k;
        const int rowc = rownA[k];
        const u32x4 Kc0 = KfA[k][0], Kc1 = KfA[k][1], Qc0 = QfA[k][0], Qc1 = QfA[k][1], rv = rvA[k];
        const float ec0 = e15A[k][0], ec1 = e15A[k][1], ec2 = e15A[k][2], ec3 = e15A[k][3];
        *(LAS u32x4*)(VL + li * 32 + quad * 8) = rv;
        *(LAS u32x4*)(KL + li * 64 + quad * 8) = Kc0; *(LAS u32x4*)(KL + li * 64 + 32 + quad * 8) = Kc1;
        if (ch + 4 < NSTEP / 16) HG_LOAD(ch + 4, k);
        asm volatile("" ::: "memory");
        unsigned va[2][4], ka4[4][4]; u32x4 Sf[2][2];
#pragma unroll
        for (int vt = 0; vt < 2; ++vt) { const LAS bf16_t* vp = VL + (quad * 4) * 32 + 16 * vt + li; va[vt][0] = vp[0]; va[vt][1] = vp[32]; va[vt][2] = vp[64]; va[vt][3] = vp[96]; }
#pragma unroll
        for (int kt4 = 0; kt4 < 4; ++kt4) { const LAS bf16_t* kp = KL + (quad * 4) * 64 + 16 * kt4 + li; ka4[kt4][0] = kp[0]; ka4[kt4][1] = kp[64]; ka4[kt4][2] = kp[128]; ka4[kt4][3] = kp[192]; }
#pragma unroll
        for (int vt = 0; vt < 2; ++vt) { Sf[vt][0] = *(const LAS u32x4*)(SL + (16 * vt + li) * 72 + quad * 8); Sf[vt][1] = *(const LAS u32x4*)(SL + (16 * vt + li) * 72 + 32 + quad * 8); }
        __builtin_amdgcn_sched_barrier(0);
        u32x4 Af;
        {
            f32x4 acc = (f32x4){0.f, 0.f, 0.f, 0.f};
            acc = __builtin_amdgcn_mfma_f32_16x16x32_bf16(as_bf8(Kc0), as_bf8(Qc0), acc, 0, 0, 0);
            acc = __builtin_amdgcn_mfma_f32_16x16x32_bf16(as_bf8(Kc1), as_bf8(Qc1), acc, 0, 0, 0);
#pragma unroll
            for (int jj = 0; jj < 4; ++jj) if (quad * 4 + jj > li) acc[jj] = 0.f;
            Af = (u32x4){pkbf(acc[0], acc[1]), pkbf(acc[2], acc[3]), 0u, 0u};
        }
        u32x4 VT[2];
#pragma unroll
        for (int vt = 0; vt < 2; ++vt) VT[vt] = (u32x4){va[vt][0] | (va[vt][1] << 16), va[vt][2] | (va[vt][3] << 16), 0u, 0u};
#pragma unroll
        for (int vt = 0; vt < 2; ++vt) {
            f32x4 acc = (f32x4){0.f, 0.f, 0.f, 0.f};
            acc = __builtin_amdgcn_mfma_f32_16x16x32_bf16(as_bf8(VT[vt]), as_bf8(Af), acc, 0, 0, 0);
            acc = __builtin_amdgcn_mfma_f32_16x16x32_bf16(as_bf8(Sf[vt][0]), as_bf8(Qc0), acc, 0, 0, 0);
            acc = __builtin_amdgcn_mfma_f32_16x16x32_bf16(as_bf8(Sf[vt][1]), as_bf8(Qc1), acc, 0, 0, 0);
            u32x2 o; o.x = pkbf(acc[0], acc[1]); o.y = pkbf(acc[2], acc[3]);
            *(u32x2*)(Y + (size_t)rowc * DM + ycol + 16 * vt + quad * 4) = o;
        }
#pragma unroll
        for (int kt4 = 0; kt4 < 4; ++kt4) {
            const u32x4 kT = (u32x4){ka4[kt4][0] | (ka4[kt4][1] << 16), ka4[kt4][2] | (ka4[kt4][3] << 16), 0u, 0u};
            const float e = kt4 == 0 ? ec0 : (kt4 == 1 ? ec1 : (kt4 == 2 ? ec2 : ec3));
#pragma unroll
            for (int vt = 0; vt < 2; ++vt) {
                Sacc[vt][kt4] = __builtin_amdgcn_mfma_f32_16x16x32_bf16(as_bf8(VT[vt]), as_bf8(kT), Sacc[vt][kt4], 0, 0, 0);
                Sacc[vt][kt4] = Sacc[vt][kt4] * e;
                const unsigned s01 = pkbf(Sacc[vt][kt4][0], Sacc[vt][kt4][1]), s23 = pkbf(Sacc[vt][kt4][2], Sacc[vt][kt4][3]);
                LAS bf16_t* sp = SL + (16 * vt + quad * 4) * 72 + 16 * kt4 + li;
                sp[0] = (bf16_t)(s01 & 0xffffu); sp[72] = (bf16_t)(s01 >> 16); sp[144] = (bf16_t)(s23 & 0xffffu); sp[216] = (bf16_t)(s23 >> 16);
            }
        }
        asm volatile("" ::: "memory");
      }
    }
#undef HG_LOAD
}

__device__ __forceinline__ void s5_coef(float lre, float lim, float stp, float& ar, float& ai, float& kr, float& ki) {
    const float mag = __expf(lre * stp);
    float ang = lim * stp; { const float kq = rintf(ang * 0.15915494309f); ang = fmaf(-kq, 6.2831855f, ang); ang = fmaf(-kq, -1.7484555e-7f, ang); }
    float sn, cs; sincosf(ang, &sn, &cs);
    ar = mag * cs; ai = mag * sn;
    const float den = lre * lre + lim * lim, nr = ar - 1.0f; kr = (nr * lre + ai * lim) / den; ki = (ai * lre - nr * lim) / den;
}
__device__ __forceinline__ void s5_unit(const KP P, int l, int b, int dir, int g, LAS float* wl, int lane) {
    const bool colmajor = (l & 1) != 0;
    const bf16_t* p = (const bf16_t*)(P.ws() + WS_P);
    bf16_t* Y = (bf16_t*)(P.ws() + (dir ? WS_YB : WS_YF));
    LAS float* Ub = wl; LAS int* Rb = (LAS int*)(wl + 256); LAS bf16_t* XB = (LAS bf16_t*)(wl + 512);
    LAS float* VLs = wl + 1600;
    const int idx = (l * 2 + dir) * 16 + g, n = lane, li = lane & 15, c = lane & 15, quad = lane >> 4;
    const float stp = __expf(P.in(I_LSTEP)[idx]);
    float ar, ai;
    { float kr_, ki_; s5_coef(P.in(I_LRE)[idx * 64 + n], P.in(I_LIM)[idx * 64 + n], stp, ar, ai, kr_, ki_); }
    u32x4 Btf[8];
#pragma unroll
    for (int T = 0; T < 4; ++T) {
        const int n2 = 16 * T + li;
        float ar2, ai2, kr, ki; s5_coef(P.in(I_LRE)[idx * 64 + n2], P.in(I_LIM)[idx * 64 + n2], stp, ar2, ai2, kr, ki);
        u32x4 wr = (u32x4){0u, 0u, 0u, 0u}, wi = wr;
        if (quad < 2) {
            const float* br = P.in(I_BRE) + (size_t)(idx * 64 + n2) * 16 + quad * 8; const float* bi = P.in(I_BIM) + (size_t)(idx * 64 + n2) * 16 + quad * 8;
            const f32x4 r0 = *(const f32x4*)br, r1 = *(const f32x4*)(br + 4), i0 = *(const f32x4*)bi, i1 = *(const f32x4*)(bi + 4);
            const f32x4 a0 = r0 * kr - i0 * ki, a1 = r1 * kr - i1 * ki, b0 = i0 * kr + r0 * ki, b1 = i1 * kr + r1 * ki;
            wr = (u32x4){pkbf(a0.x, a0.y), pkbf(a0.z, a0.w), pkbf(a1.x, a1.y), pkbf(a1.z, a1.w)};
            wi = (u32x4){pkbf(b0.x, b0.y), pkbf(b0.z, b0.w), pkbf(b1.x, b1.y), pkbf(b1.z, b1.w)};
        }
        Btf[T] = wr; Btf[T + 4] = wi;
    }
    bf16x8 Cop[4];
#pragma unroll
    for (int kk = 0; kk < 4; ++kk) {
        const float* srcp = (kk < 2 ? P.in(I_CRE) : P.in(I_CIM)) + (size_t)(idx * 16 + c) * 64 + (kk & 1) * 32 + quad * 8;
        const f32x4 v0 = *(const f32x4*)srcp, v1 = *(const f32x4*)(srcp + 4);
        const float sg = kk < 2 ? 1.0f : -1.0f;
        u32x4 w; w.x = pkbf(sg * v0.x, sg * v0.y); w.y = pkbf(sg * v0.z, sg * v0.w); w.z = pkbf(sg * v1.x, sg * v1.y); w.w = pkbf(sg * v1.z, sg * v1.w);
        Cop[kk] = __builtin_bit_cast(bf16x8, w);
    }
    const float dsk = dir == 0 ? P.in(I_S5D)[l * 256 + g * 16 + c] : 0.f;
    float xr = 0.f, xi = 0.f;
    u32x4 ruA[4]; int rownA[4];
#pragma unroll
    for (int k = 0; k < 4; ++k) ruA[k] = (u32x4){0u, 0u, 0u, 0u};
#define S5_LOAD(ch, k) do { rownA[k] = seq_row(b, dir, (ch) * 16 + li, colmajor); if (quad < 2) ruA[k] = *(const u32x4*)(p + (size_t)rownA[k] * INC + PC_S5 + g * 16 + quad * 8); } while (0)
#pragma unroll
    for (int k = 0; k < 4; ++k) S5_LOAD(k, k);
#pragma unroll 1
    for (int ch0 = 0; ch0 < NSTEP / 16; ch0 += 4) {
#pragma unroll
      for (int k = 0; k < 4; ++k) {
        const int ch = ch0 + k;
        const u32x4 uc = ruA[k]; const int rown = rownA[k];
        if (quad < 2) { float t[8]; unpack8(uc, t); *(LAS f32x4*)(Ub + li * 16 + quad * 8) = (f32x4){t[0], t[1], t[2], t[3]}; *(LAS f32x4*)(Ub + li * 16 + quad * 8 + 4) = (f32x4){t[4], t[5], t[6], t[7]}; }
        if (quad == 0) Rb[li] = rown;
        if (ch + 4 < NSTEP / 16) S5_LOAD(ch + 4, k);
#pragma unroll
        for (int T = 0; T < 8; ++T) {
            const f32x4 acc = __builtin_amdgcn_mfma_f32_16x16x32_bf16(as_bf8(uc), as_bf8(Btf[T]), (f32x4){0.f, 0.f, 0.f, 0.f}, 0, 0, 0);
            *(LAS f32x4*)(VLs + (16 * T + li) * 20 + quad * 4) = acc;
        }
        asm volatile("" ::: "memory");
        f32x4 vr4[4], vi4[4];
#pragma unroll
        for (int q = 0; q < 4; ++q) { vr4[q] = *(const LAS f32x4*)(VLs + n * 20 + 4 * q); vi4[q] = *(const LAS f32x4*)(VLs + (64 + n) * 20 + 4 * q); }
        __builtin_amdgcn_sched_barrier(0);
#pragma unroll
        for (int s = 0; s < 16; ++s) {
            const float nxr = ar * xr - ai * xi + vr4[s >> 2][s & 3], nxi = ar * xi + ai * xr + vi4[s >> 2][s & 3];
            xr = nxr; xi = nxi;
            const unsigned pw = pkbf(xr, xi);
            XB[s * 136 + n] = (bf16_t)(pw & 0xffffu); XB[s * 136 + 64 + n] = (bf16_t)(pw >> 16);
        }
        asm volatile("" ::: "memory");
        f32x4 acc = (f32x4){0.f, 0.f, 0.f, 0.f};
#pragma unroll
        for (int kk = 0; kk < 4; ++kk) { const bf16x8 a = *(const LAS bf16x8*)(XB + c * 136 + 32 * kk + quad * 8); acc = __builtin_amdgcn_mfma_f32_16x16x32_bf16(a, Cop[kk], acc, 0, 0, 0); }
#pragma unroll
        for (int j = 0; j < 4; ++j) { const int t = quad * 4 + j; const int rt = Rb[t]; const float yv = acc[j] + dsk * Ub[t * 16 + c];
            Y[(size_t)rt * DM + 512 + g * 16 + c] = (bf16_t)(pkbf(yv, 0.f) & 0xffffu); }
        asm volatile("" ::: "memory");
      }
    }
#undef S5_LOAD
}

__device__ __forceinline__ void scan_phase(const KP P, int l, LAS unsigned char* lds, int wid, int lane, int bid) {
    const int v = (bid & 7) * 32 + (bid >> 3), b = v >> 3, dir = (v >> 2) & 1;
    if (wid < 4) {
        const int h = ((v >> 1) & 1) * 4 + (v & 1) * 2 + (wid >> 1), half = wid & 1;
        ssd_mfma_unit(P, l, ((b * 2 + dir) * 8 + h) * 2 + half, lds + wid * 22528, lane);
        if (wid >= 2) { int lane2 = lane; asm volatile("" : "+v"(lane2)); hg_mfma_unit(P, l, ((b * 2 + dir) * 4 + (v & 3)) * 2 + (wid - 2), lds + wid * 22528, lane2); }
    } else {
        LAS unsigned char* wlb = lds + 90112 + (wid - 4) * 16896;
        s5_unit(P, l, b, dir, (v & 3) * 4 + (wid - 4), (LAS float*)wlb, lane);
    }
}

struct CombIn { u32x4 ya, yb, z; u32x2 fa, fb, ha, hb, gg; };
__device__ __forceinline__ CombIn comb_load(const bf16_t* p, const bf16_t* Yf, const bf16_t* Yb, int row, int lane) {
    CombIn r; const int c8 = lane * 8, c4 = lane * 4;
    r.ya = *(const u32x4*)(Yf + (size_t)row * DM + c8); r.yb = *(const u32x4*)(Yb + (size_t)row * DM + c8); r.z = *(const u32x4*)(p + (size_t)row * INC + c8);
    r.fa = *(const u32x2*)(Yf + (size_t)row * DM + 512 + c4); r.fb = *(const u32x2*)(Yb + (size_t)row * DM + 512 + c4);
    r.ha = *(const u32x2*)(Yf + (size_t)row * DM + 768 + c4); r.hb = *(const u32x2*)(Yb + (size_t)row * DM + 768 + c4);
    r.gg = *(const u32x2*)(p + (size_t)row * INC + PC_G + c4);
    return r;
}
__device__ __forceinline__ void comb_row(const CombIn& r, bf16_t* mix, bf16_t* ybuf, const float* anw, const float* hnw, int row, int lane) {
    {
        const int c = lane * 8;
        float a[8], bq[8], z[8];
        unpack8(r.ya, a); unpack8(r.yb, bq); unpack8(r.z, z);
        float ss = 0.f;
#pragma unroll
        for (int j = 0; j < 8; ++j) { a[j] = (a[j] + bq[j]) * siluf_(z[j]); ss += a[j] * a[j]; }
        const float rstd = rsqrtf(wave_sum(ss, lane) * (1.0f / 512.0f) + EPS);
        const f32x4 w0 = *(const f32x4*)(anw + c), w1 = *(const f32x4*)(anw + c + 4);
        u32x4 w; w.x = pkbf(a[0] * rstd * w0.x, a[1] * rstd * w0.y); w.y = pkbf(a[2] * rstd * w0.z, a[3] * rstd * w0.w);
        w.z = pkbf(a[4] * rstd * w1.x, a[5] * rstd * w1.y); w.w = pkbf(a[6] * rstd * w1.z, a[7] * rstd * w1.w);
        *(u32x4*)(mix + (size_t)row * DM + c) = w;
    }
    {
        const int c = lane * 4;
        float y[4] = {bf_lo(r.fa.x) + bf_lo(r.fb.x), bf_hi(r.fa.x) + bf_hi(r.fb.x), bf_lo(r.fa.y) + bf_lo(r.fb.y), bf_hi(r.fa.y) + bf_hi(r.fb.y)};
#pragma unroll
        for (int j = 0; j < 4; ++j) { const float x = y[j]; y[j] = x * sigmoidf_(1.5957691216f * (x + 0.044715f * x * x * x)); }
        u32x2 w; w.x = pkbf(y[0], y[1]); w.y = pkbf(y[2], y[3]);
        *(u32x2*)(ybuf + (size_t)row * 256 + c) = w;
        float o[4] = {bf_lo(r.ha.x) + bf_lo(r.hb.x), bf_hi(r.ha.x) + bf_hi(r.hb.x), bf_lo(r.ha.y) + bf_lo(r.hb.y), bf_hi(r.ha.y) + bf_hi(r.hb.y)};
        float ss = (o[0] * o[0] + o[1] * o[1]) + (o[2] * o[2] + o[3] * o[3]);
        ss = row16_sum(ss);
        const float rstd = rsqrtf(ss * (1.0f / 64.0f) + EPS);
        const f32x4 nw4 = *(const f32x4*)(hnw + c);
        const float g0 = siluf_(bf_lo(r.gg.x)), g1 = siluf_(bf_hi(r.gg.x)), g2 = siluf_(bf_lo(r.gg.y)), g3 = siluf_(bf_hi(r.gg.y));
        u32x2 w2; w2.x = pkbf(o[0] * rstd * nw4.x * g0, o[1] * rstd * nw4.y * g1); w2.y = pkbf(o[2] * rstd * nw4.z * g2, o[3] * rstd * nw4.w * g3);
        *(u32x2*)(mix + (size_t)row * DM + 768 + c) = w2;
    }
}
__device__ __forceinline__ void combine_phase(const KP P, int l, int nrows, int gw, int nw, int lane) {
    const bf16_t* p = (const bf16_t*)(P.ws() + WS_P); const bf16_t* Yf = (const bf16_t*)(P.ws() + WS_YF); const bf16_t* Yb = (const bf16_t*)(P.ws() + WS_YB);
    bf16_t* mix = (bf16_t*)(P.ws() + WS_U); bf16_t* ybuf = (bf16_t*)(P.ws() + WS_YBUF);
    const float* anw = P.in(I_ANORM) + l * 512; const float* hnw = P.in(I_HGNORM) + l * 256;
    for (int row = gw; row < nrows; row += 3 * nw) {
        const int r1 = row + nw, r2 = row + 2 * nw; const bool h1 = r1 < nrows, h2 = r2 < nrows;
        const CombIn a = comb_load(p, Yf, Yb, row, lane), b = comb_load(p, Yf, Yb, h1 ? r1 : row, lane), c = comb_load(p, Yf, Yb, h2 ? r2 : row, lane);
        __builtin_amdgcn_sched_barrier(0);
        comb_row(a, mix, ybuf, anw, hnw, row, lane);
        if (h1) comb_row(b, mix, ybuf, anw, hnw, r1, lane);
        if (h2) comb_row(c, mix, ybuf, anw, hnw, r2, lane);
    }
}
#ifndef RESID_ALIGN
#define RESID_ALIGN true
#endif
constexpr int N_PHASES = 24;
__global__ void __launch_bounds__(NTHREADS, 2) fwd_kernel(Params Pk) {
    extern __shared__ __attribute__((aligned(16))) unsigned char smem[];
    LAS unsigned char* lds = (LAS unsigned char*)smem;
    cg::grid_group grid = cg::this_grid();
    const int G = gridDim.x, nw = G * 8;
    const int wid0 = __builtin_amdgcn_readfirstlane((int)threadIdx.x >> 6);
    kaptr_t ka = (kaptr_t)__builtin_amdgcn_kernarg_segment_ptr();
    const int ph_lo = KP{ka}.ph_lo(), ph_hi = KP{ka}.ph_hi();
    volatile LAS unsigned* xst = (volatile LAS unsigned*)(lds + LDS_BYTES - 16);
    { const int t0 = wid0 * 64 + (int)__builtin_amdgcn_mbcnt_hi(~0u, __builtin_amdgcn_mbcnt_lo(~0u, 0u)); if (t0 < 4) xst[t0] = 0u; __syncthreads(); }
    const XcdBarrier xbar = xcd_barrier_post((unsigned*)KP{ka}.ws(), xst, wid0 * 64 + (int)__builtin_amdgcn_mbcnt_hi(~0u, __builtin_amdgcn_mbcnt_lo(~0u, 0u)));
#ifdef PROBE_Q
    for (int pp = ph_lo; pp < ph_hi + 2; ++pp) {
        const int ph = pp <= 3 + PROBE_Q ? pp : (pp <= 14 + PROBE_Q ? pp - 1 : pp - 2);
        if (pp > ph_lo) grid.sync();
#else
    for (int ph = ph_lo; ph < ph_hi; ++ph) {
        unsigned zero_ = 0u; asm volatile("" : "+v"(zero_));
        int tid = wid0 * 64 + (int)__builtin_amdgcn_mbcnt_hi(~0u, __builtin_amdgcn_mbcnt_lo(~0u, zero_)); asm volatile("" : "+v"(tid));
        if (ph == ph_lo + 1) grid.sync();
        else if (ph > ph_lo) xcd_barrier(xbar, tid);
#ifdef PROBE_SYNC
        if (ph > ph_lo) { grid.sync(); grid.sync(); }
#endif
#endif
        asm volatile("" : "+s"(ka));
        const KP P{ka};
        unsigned char* ws = P.ws();
        float* hctx = (float*)(ws + WS_HCTX); bf16_t* ub = (bf16_t*)(ws + WS_U); bf16_t* pb = (bf16_t*)(ws + WS_P);
        float* SS = (float*)(ws + WS_SS);
        int bid = blockIdx.x; asm volatile("" : "+s"(bid));
        const int lane = tid & 63, wid = __builtin_amdgcn_readfirstlane(tid >> 6), gw = bid * 8 + wid;
        if (ph == 0) { prologue_phase(P, lds, tid, wid, lane, bid); continue; }
        if (ph == 1) { modreduce_phase(P, bid * NTHREADS + tid, G * NTHREADS); continue; }
        if (ph == 2) { prep_phase(P, lds, tid, gw, nw, lane); continue; }
        if (ph == N_PHASES - 1) { final_phase(P.out(), P.in(I_FNORM), gw, nw, lane); continue; }
        const int l = (ph - 3) / 10, q = (ph - 3) - l * 10;
        const float* modl = (const float*)(ws + WS_MOD) + (size_t)l * 33 * MODW;
        unsigned char* wlp = ws + WS_W + (size_t)l * W_LAYER;
        const float* biasl = (const float*)(ws + WS_BIAS) + (size_t)l * 3 * BIAS_TAB;
        const int nrows_late = l == 1 ? MLAT : MALL;
        const bool first = (l == 0 && q <= 1);
        const float* srcLat = first ? P.in(I_X) : P.out(); const float* srcCtx = first ? P.in(I_CTX) : hctx;
        if (q == 0 || q == 8) {
            const int j = q == 8 ? 1 : 0, M = j ? nrows_late : MALL;
            pg8::Gemm g{j ? (const bf16_t*)(ws + WS_YF) : ub, (const bf16_t*)(wlp + WO_FI + (size_t)j * FI_BYTES), M, 2 * DFF, DM}; pg8::StaticOrder S; S.init(M, 2 * DFF, G, bid);
            rstd_prestep(S, SS, lds, tid);
            pg8::EpiSwiglu E{pb, lds + 131072, biasl + (size_t)(j ? 2 : 0) * BIAS_TAB};
            pg8::gemm_phase<pg8::EpiSwiglu, pg8::StaticOrder, true, true>(lds, g, S, E, tid);
        } else if (q == 1 || q == 7 || q == 9) {
            const int M = q == 1 ? MALL : nrows_late;
            const bf16_t* A = q == 7 ? ub : pb;
            const bf16_t* Bt = (const bf16_t*)(q == 7 ? wlp + WO_WOUT : wlp + WO_FO + (size_t)(q == 9 ? 1 : 0) * FO_BYTES);
            const int K = q == 7 ? DM : DFF;
            pg8::Gemm g{A, Bt, M, DM, K}; pg8::StaticOrder S; S.init(M, DM, G, bid); S.rev = 1;
            pg8::EpiResid E{ka, l, q};
            pg8::gemm_phase<pg8::EpiResid, pg8::StaticOrder, RESID_ALIGN, true>(lds, g, S, E, tid);
        } else if (q == 2) {
            pg8::Gemm g{ub, (const bf16_t*)(wlp + WO_WIN), MALL, INCP, DM}; pg8::StaticOrder S; S.init(MALL, INCP, G, bid);
            rstd_prestep(S, SS, lds, tid);
            pg8::EpiP E{pb, INC, INC, lds + 131072, biasl + (size_t)1 * BIAS_TAB};
            pg8::gemm_phase<pg8::EpiP, pg8::StaticOrder, true, true>(lds, g, S, E, tid);
        } else if (q == 3) {
            conv_phase(pb, ub, P.in(I_CONVW) + l * 5 * 768, P.in(I_CONVB) + l * 768, l == 1, bid * NTHREADS + tid, G * NTHREADS);
            hg_prepass(P, l, gw, nw, lane);
        } else if (q == 4) {
            scan_phase(P, l, lds, wid, lane, bid);
        } else if (q == 5) {
            combine_phase(P, l, nrows_late, gw, nw, lane);
        } else if (q == 6) {
            const bf16_t* yb = (const bf16_t*)(ws + WS_YBUF);
            int kglu = 256; asm volatile("" : "+s"(kglu));
            pg8::Gemm g{yb, (const bf16_t*)(wlp + WO_GLU), nrows_late, 256, kglu}; pg8::StaticOrder S; S.init(nrows_late, 256, G, bid);
            pg8::EpiGlu E{yb, ub, P.in(I_GLUB) + l * 256};
            pg8::gemm_phase<pg8::EpiGlu, pg8::StaticOrder, true, true>(lds, g, S, E, tid);
        }
    }
}

extern "C" void kernel_launch(void* const* d_in, const int* in_sizes, int n_in, void* d_out, int out_size, void* d_ws, size_t ws_size, hipStream_t stream) {
    static int grid = 0;
    if (grid == 0) {
        if (n_in != 29 || out_size != MLAT * DM || ws_size < WS_END) { fprintf(stderr, "kernel_launch: unexpected shapes (n_in %d out %d ws %zu)\n", n_in, out_size, ws_size); grid = -1; return; }
        int dev = 0, cus = 0, per_cu = 0;
        (void)hipGetDevice(&dev); (void)hipDeviceGetAttribute(&cus, hipDeviceAttributeMultiprocessorCount, dev);
        if (hipFuncSetAttribute((const void*)fwd_kernel, hipFuncAttributeMaxDynamicSharedMemorySize, LDS_BYTES) != hipSuccess) { fprintf(stderr, "kernel_launch: hipFuncSetAttribute failed\n"); grid = -1; return; }
        if (hipOccupancyMaxActiveBlocksPerMultiprocessor(&per_cu, (const void*)fwd_kernel, NTHREADS, LDS_BYTES) != hipSuccess || per_cu < 1) { fprintf(stderr, "kernel_launch: occupancy query says %d\n", per_cu); per_cu = 1; }
        (void)hipGetLastError();
        grid = cus * per_cu;
        if (grid < 256) { fprintf(stderr, "kernel_launch: needs 256 co-resident workgroups, have %d\n", grid); grid = -1; return; }
        grid = 256;
        fprintf(stderr, "kernel_launch: grid %d (cus %d x %d)\n", grid, cus, per_cu);
    }
    if (grid < 0) return;
    if (hipMemsetAsync(d_ws, 0, 16384, stream) != hipSuccess) { fprintf(stderr, "kernel_launch: memset of the barrier words failed\n"); return; }
    Params p{};
    for (int i = 0; i < 29; ++i) p.in[i] = (const float*)d_in[i];
    p.out = (float*)d_out; p.ws = (unsigned char*)d_ws;
#ifdef MULTI_LAUNCH
    for (int ph = 0; ph < N_PHASES; ++ph) { p.ph_lo = ph; p.ph_hi = ph + 1; hipLaunchKernelGGL(fwd_kernel, dim3(grid), dim3(NTHREADS), LDS_BYTES, stream, p); }
#else
    p.ph_lo = 0; p.ph_hi = N_PHASES;
    void* args[] = {&p};
    hipError_t e = hipLaunchCooperativeKernel((const void*)fwd_kernel, dim3(grid), dim3(NTHREADS), args, LDS_BYTES, stream);
    if (e != hipSuccess) fprintf(stderr, "kernel_launch: cooperative launch failed: %s (grid %d)\n", hipGetErrorString(e), grid);
#endif
}
```
